# Optimizing an MI355X kernel written in HIP

```python
import jax, jax.numpy as jnp
from jax import lax
import numpy as np

D_MODEL = 1024
BATCH = 8
SEQ = 2048
DEPTH = 4
DEC_BATCH = 128
DEC_SEQ = 8
PAST_LEN = 16384
PAGE_SIZE = 128

POOL_WIDTH = D_MODEL // 2
POOL_WINDOWS = (2, 4, 8, 16)
N_POOL_GROUPS = len(POOL_WINDOWS)
POOL_GROUP_DIM = POOL_WIDTH // N_POOL_GROUPS
POOL_BUF = max(POOL_WINDOWS) - 1
SG_WIDTH = D_MODEL - POOL_WIDTH
SG_HEADS = 4
SG_HEAD_DIM = SG_WIDTH // SG_HEADS
CHUNK = 128
MIX_WIDTH = POOL_WIDTH + SG_WIDTH
IN_WIDTH = POOL_WIDTH + 2 * SG_WIDTH
D_FF = ((8 * D_MODEL // 3 + 127) // 128) * 128
CONV_WIDTH = 3
CONV_BUF = CONV_WIDTH - 1
EPS = 1e-6

kernel_name = "hybrid_pool_sgmlp_convffn_step"


def rmsnorm(x, g):
    x32 = x.astype(jnp.float32)
    y = x32 * lax.rsqrt(jnp.mean(x32 * x32, axis=-1, keepdims=True) + EPS)
    return (y * g.astype(jnp.float32)).astype(x.dtype)


def pool_mixer(p, past, pos0, w_pool, scale):
    B, T, _ = p.shape
    full = jnp.concatenate([past.astype(p.dtype), p], axis=1)
    csum = jnp.cumsum(full.astype(jnp.float32), axis=1)
    c = jnp.concatenate([jnp.zeros((B, 1, POOL_WIDTH), jnp.float32), csum], axis=1)
    pos = pos0 + jnp.arange(T)
    end = c[:, POOL_BUF + 1:POOL_BUF + 1 + T]
    means = []
    for gi, w in enumerate(POOL_WINDOWS):
        sl = slice(gi * POOL_GROUP_DIM, (gi + 1) * POOL_GROUP_DIM)
        start = c[:, POOL_BUF + 1 - w:POOL_BUF + 1 - w + T, sl]
        cnt = jnp.minimum(pos + 1, w).astype(jnp.float32)[None, :, None]
        means.append((end[..., sl] - start) / cnt)
    d = jnp.concatenate(means, axis=-1) - p.astype(jnp.float32)
    d = d.reshape(B, T, N_POOL_GROUPS, POOL_GROUP_DIM)
    out = jnp.einsum('btgc,gcd->btgd', d, w_pool.astype(jnp.float32)).reshape(B, T, POOL_WIDTH)
    out = out * scale.astype(jnp.float32)
    return out.astype(p.dtype), full[:, -POOL_BUF:]


def spatial_gate(u, v, w_s, b_s):
    B, T, _ = u.shape
    L = min(T, CHUNK)
    nc = T // L
    u = u.reshape(B, nc, L, SG_HEADS, SG_HEAD_DIM)
    v = v.reshape(B, nc, L, SG_HEADS, SG_HEAD_DIM)
    mask = jnp.tril(jnp.ones((L, L), dtype=bool))
    w = jnp.where(mask[None], w_s[:, :L, :L], jnp.zeros((), w_s.dtype))
    mixed = jnp.einsum('hts,bcshd->bcthd', w, v) + b_s[:, :L].T[None, None, :, :, None]
    return (u * mixed).reshape(B, T, SG_WIDTH)


def conv_ffn(h, past, w_gate, w_up, conv_w, conv_b, w_down):
    T = h.shape[1]
    g = h @ w_gate
    full = jnp.concatenate([past.astype(g.dtype), g], axis=1)
    conv = conv_b + sum(conv_w[k] * full[:, k:k + T] for k in range(CONV_WIDTH))
    y = (jax.nn.gelu(conv, approximate=False) * (h @ w_up)) @ w_down
    return y, full[:, -CONV_BUF:]


def layer(x, pool_past, conv_past, pos0, norm1_g, w_in, pool_w, pool_scale, v_norm_g,
          w_spatial, b_spatial, w_out, norm2_g, w_gate, w_up, conv_w, conv_b, w_down):
    h = rmsnorm(x, norm1_g)
    z = h @ w_in
    p = z[..., :POOL_WIDTH]
    uv = jax.nn.gelu(z[..., POOL_WIDTH:], approximate=False)
    u = uv[..., :SG_WIDTH]
    v = rmsnorm(uv[..., SG_WIDTH:], v_norm_g)
    a, pool_state = pool_mixer(p, pool_past, pos0, pool_w, pool_scale)
    s = spatial_gate(u, v, w_spatial, b_spatial)
    x = x + jnp.concatenate([a, s], axis=-1) @ w_out
    y, conv_state = conv_ffn(rmsnorm(x, norm2_g), conv_past, w_gate, w_up, conv_w, conv_b, w_down)
    return x + y, pool_state, conv_state, v


def setup_inputs(seed: int = 0) -> dict:
    key = jax.random.key(seed)
    ks = jax.random.split(key, 20)
    f32 = jnp.float32
    nrm = lambda k, shape, s: (jax.random.normal(k, shape, f32) * s)
    return {
        "x_prompt": nrm(ks[0], (BATCH, SEQ, D_MODEL), 1.0),
        "x_sample": nrm(ks[1], (DEC_BATCH, DEC_SEQ, D_MODEL), 1.0),
        "state_pool": nrm(ks[2], (DEPTH, DEC_BATCH, POOL_BUF, POOL_WIDTH), 1.0),
        "state_conv": nrm(ks[3], (DEPTH, DEC_BATCH, CONV_BUF, D_FF), 1.0),
        "norm1_g": 1.0 + nrm(ks[4], (DEPTH, D_MODEL), 0.05),
        "w_in": nrm(ks[5], (DEPTH, D_MODEL, IN_WIDTH), D_MODEL ** -0.5),
        "pool_w": nrm(ks[6], (DEPTH, N_POOL_GROUPS, POOL_GROUP_DIM, POOL_GROUP_DIM), POOL_GROUP_DIM ** -0.5),
        "pool_scale": 1.0 + nrm(ks[7], (DEPTH, POOL_WIDTH), 0.1),
        "v_norm_g": 1.0 + nrm(ks[8], (DEPTH, SG_WIDTH), 0.05),
        "w_spatial": nrm(ks[9], (DEPTH, SG_HEADS, CHUNK, CHUNK), 0.5 * CHUNK ** -0.5),
        "b_spatial": 1.0 + nrm(ks[10], (DEPTH, SG_HEADS, CHUNK), 0.1),
        "w_out": nrm(ks[11], (DEPTH, MIX_WIDTH, D_MODEL), MIX_WIDTH ** -0.5),
        "norm2_g": 1.0 + nrm(ks[12], (DEPTH, D_MODEL), 0.05),
        "w_gate": nrm(ks[13], (DEPTH, D_MODEL, D_FF), D_MODEL ** -0.5),
        "w_up": nrm(ks[14], (DEPTH, D_MODEL, D_FF), D_MODEL ** -0.5),
        "conv_w": nrm(ks[15], (DEPTH, CONV_WIDTH, D_FF), 0.5),
        "conv_b": nrm(ks[16], (DEPTH, D_FF), 0.01),
        "w_down": nrm(ks[17], (DEPTH, D_FF, D_MODEL), D_FF ** -0.5),
        "final_norm_g": 1.0 + nrm(ks[18], (D_MODEL,), 0.05),
    }


def reference(x_prompt, x_sample, state_pool, state_conv, norm1_g, w_in, pool_w, pool_scale,
              v_norm_g, w_spatial, b_spatial, w_out, norm2_g, w_gate, w_up, conv_w, conv_b,
              w_down, final_norm_g):
    xp, xs = x_prompt, x_sample
    zero_pool = jnp.zeros((BATCH, POOL_BUF, POOL_WIDTH), x_prompt.dtype)
    zero_conv = jnp.zeros((BATCH, CONV_BUF, D_FF), x_prompt.dtype)
    pool_p, pool_s, conv_p, conv_s, v_s = [], [], [], [], []
    for i in range(DEPTH):
        params = (norm1_g[i], w_in[i], pool_w[i], pool_scale[i], v_norm_g[i], w_spatial[i],
                  b_spatial[i], w_out[i], norm2_g[i], w_gate[i], w_up[i], conv_w[i], conv_b[i], w_down[i])
        xp, ps, cs, _ = layer(xp, zero_pool, zero_conv, 0, *params)
        pool_p.append(ps)
        conv_p.append(cs)
        xs, ps, cs, vs = layer(xs, state_pool[i], state_conv[i], PAST_LEN, *params)
        pool_s.append(ps)
        conv_s.append(cs)
        v_s.append(vs)
    y_prompt = rmsnorm(xp, final_norm_g)
    y_sample = rmsnorm(xs, final_norm_g)
    return (y_prompt, y_sample, jnp.stack(pool_p), jnp.stack(pool_s), jnp.stack(conv_p),
            jnp.stack(conv_s), jnp.stack(v_s))
```

```cpp
#include <hip/hip_runtime.h>
#include <hip/hip_cooperative_groups.h>
#include <cstdio>
namespace cg = cooperative_groups;

#define LAS __attribute__((address_space(3)))
typedef unsigned short bf16_t;
typedef short bf16x8 __attribute__((ext_vector_type(8)));
typedef float f32x4 __attribute__((ext_vector_type(4)));
typedef unsigned u32x4 __attribute__((ext_vector_type(4)));
typedef unsigned u32x2 __attribute__((ext_vector_type(2)));

constexpr int D = 1024, MP = 16384, MT = 17408, INW = 1536, FF = 2816, NGU = 5632;
constexpr float EPS = 1e-6f;

constexpr size_t O_POOLP = 17825792, O_POOLS = 18071552, O_CONVP = 22003712, O_CONVS = 22183936, O_VS = 25067520;
constexpr size_t WS_WIN = 0, WS_WOUT = 12582912, WS_WGU = 20971520, WS_WDN = 67108864, WS_PWT = 90177536, WS_WSB = 90701824,
                 WS_XB = 91226112, WS_R1 = 126877696, WS_HALO = 224919552, WS_FIX = 228005888, WS_STAT = 234178560, WS_VSP = 235292672, WS_BAR = 235849728, WS_END = 235937280;
constexpr size_t R1_ZP = 0, R1_ZU = 17825792, R1_ZV = 35651584, R1_MIX = 53477376;
constexpr int LDS_BYTES = 131072 + 16;

struct Params {
    const float* in[19];
    float* out;
    unsigned char* ws;
};
enum { I_XP = 0, I_XS, I_SPOOL, I_SCONV, I_N1G, I_WIN, I_POOLW, I_PSCALE, I_VNG, I_WSP, I_BSP, I_WOUT, I_N2G, I_WGATE, I_WUP, I_CONVW, I_CONVB, I_WDOWN, I_FNG };

__device__ __forceinline__ unsigned cvt_pk_bf16(float lo, float hi) { unsigned r; asm("v_cvt_pk_bf16_f32 %0, %1, %2" : "=v"(r) : "v"(lo), "v"(hi)); return r; }
__device__ __forceinline__ bf16_t f2bf(float f) { return (bf16_t)(cvt_pk_bf16(f, 0.f) & 0xffffu); }
__device__ __forceinline__ float bf2f(bf16_t b) { return __uint_as_float(((unsigned)b) << 16); }
__device__ __forceinline__ float bflo(unsigned w) { return __uint_as_float(w << 16); }
__device__ __forceinline__ float bfhi(unsigned w) { return __uint_as_float(w & 0xffff0000u); }
__device__ __forceinline__ float gelu_f(float v) {
    const float av = fabsf(v), d = av * 0.2316418882f + 1.0f;
    const float t = __builtin_amdgcn_rcpf(d);
    float q = t * 0.5307027145f + (-0.7265760135f); q = q * t + 0.7107068705f; q = q * t + (-0.142248368f); q = q * t + 0.127414796f; q = q * t;
    const float e = __builtin_amdgcn_exp2f(v * v * (-0.72134752044f));
    const float m = v * (q * e);
    return v < 0.f ? m : v - m;
}
typedef float f32x2 __attribute__((ext_vector_type(2)));
__device__ __forceinline__ f32x2 gelu_pk(f32x2 v) {
    const f32x2 av = __builtin_elementwise_abs(v), d = av * 0.2316418882f + 1.0f;
    f32x2 t; t.x = __builtin_amdgcn_rcpf(d.x); t.y = __builtin_amdgcn_rcpf(d.y);
    f32x2 q = t * 0.5307027145f + (-0.7265760135f); q = q * t + 0.7107068705f; q = q * t + (-0.142248368f); q = q * t + 0.127414796f; q = q * t;
    const f32x2 u = v * 0.8493218003f, s = -(u * u);
    f32x2 e; e.x = __builtin_amdgcn_exp2f(s.x); e.y = __builtin_amdgcn_exp2f(s.y);
    const f32x2 h = 0.5f - q * e;
    return v * 0.5f + av * h;
}
__device__ __forceinline__ f32x4 gelu4(f32x4 v) { const f32x2 a = gelu_pk((f32x2){v[0], v[1]}), b = gelu_pk((f32x2){v[2], v[3]}); return (f32x4){a.x, a.y, b.x, b.y}; }
__device__ __forceinline__ float sum16(const float* p) { const f32x4 a = *(const f32x4*)p, b = *(const f32x4*)(p + 4), c = *(const f32x4*)(p + 8), d = *(const f32x4*)(p + 12); const f32x4 s = (a + b) + (c + d); return (s[0] + s[1]) + (s[2] + s[3]); }
__device__ __forceinline__ float wave_sum(float v) {
#pragma unroll
    for (int o = 1; o < 64; o <<= 1) v += __shfl_xor(v, o);
    return v;
}

__device__ __forceinline__ int opaque_tid() { int t = threadIdx.x; asm volatile("" : "+v"(t)); return t; }

#define XB_TMO      128
#define XB_XCNT(j)  (256  + 64 * (j))
#define XB_XSUB(j)  (1280 + 64 * (j))
#define XB_XGEN(j)  (2304 + 64 * (j))
#define XB_TOP      3328
#define XB_TOPGEN   3392
#define XCD_BAR_WORDS 3456
#define XB_SPIN_CAP (1u << 22)
__device__ __forceinline__ unsigned xb_ld(unsigned* p)              { return __hip_atomic_load(p, __ATOMIC_RELAXED, __HIP_MEMORY_SCOPE_AGENT); }
__device__ __forceinline__ unsigned xb_add(unsigned* p, unsigned v) { return __hip_atomic_fetch_add(p, v, __ATOMIC_RELAXED, __HIP_MEMORY_SCOPE_AGENT); }
__device__ __forceinline__ unsigned xb_xcc_id() { return (unsigned)__builtin_amdgcn_s_getreg((3 << 11) | 20) & 0xFu; }
#define XB_SPIN(cond, bar) do { unsigned _sp = 0; while (cond) { __builtin_amdgcn_s_sleep(1); \
    if ((++_sp & 255u) == 0u) { if (xb_ld(&(bar)[XB_TMO])) break; if (_sp > XB_SPIN_CAP) { atomicAdd(&(bar)[XB_TMO], 1u); break; } } } } while (0)
struct XcdBarrier { unsigned* bar; unsigned x; volatile LAS unsigned* st; };
__device__ __forceinline__ XcdBarrier xcd_barrier_post(unsigned* bar, volatile LAS unsigned* st) {
    XcdBarrier b; b.bar = bar; b.x = xb_xcc_id(); b.st = st;
    if (threadIdx.x == 0) (void)xb_add(&bar[XB_XCNT(b.x)], 1u);
    return b;
}
__device__ __forceinline__ void xcd_barrier_complete(unsigned* bar, unsigned x, unsigned& nloc, unsigned& nx) {
    const unsigned G = gridDim.x * gridDim.y * gridDim.z;
    unsigned sum, cnt, mine, sp = 0u;
    for (;;) {
        sum = 0u; cnt = 0u; mine = 0u;
#pragma unroll
        for (unsigned j = 0; j < 16; ++j) { const unsigned c = xb_ld(&bar[XB_XCNT(j)]); sum += c; cnt += (c > 0u) ? 1u : 0u; mine = (j == x) ? c : mine; }
        if (sum == G) break;
        __builtin_amdgcn_s_sleep(1);
        if ((++sp & 255u) == 0u) { if (xb_ld(&bar[XB_TMO])) break; if (sp > XB_SPIN_CAP) { atomicAdd(&bar[XB_TMO], 1u); break; } }
    }
    nloc = mine > 0u ? mine : 1u; nx = cnt > 0u ? cnt : 1u;
}
__device__ __forceinline__ void xcd_barrier(const XcdBarrier& b) {
    asm volatile("s_waitcnt vmcnt(0)" ::: "memory");
    __syncthreads();
    if (threadIdx.x == 0) {
        unsigned* bar = b.bar;
        __builtin_amdgcn_s_waitcnt(0);
        unsigned nloc = b.st[0], nx = b.st[1];
        if (nloc == 0u) { xcd_barrier_complete(bar, b.x, nloc, nx); b.st[0] = nloc; b.st[1] = nx; }
        const unsigned old = xb_add(&bar[XB_XSUB(b.x)], 1u);
        const unsigned gen = old / nloc;
        if (old + 1u == (gen + 1u) * nloc) {
            __builtin_amdgcn_fence(__ATOMIC_RELEASE, "agent");
            asm volatile("s_waitcnt vmcnt(0)" ::: "memory");
            const unsigned og = xb_add(&bar[XB_TOP], 1u);
            const unsigned tg = og / nx;
            if (og + 1u == (tg + 1u) * nx) xb_add(&bar[XB_TOPGEN], 1u);
            else XB_SPIN(xb_ld(&bar[XB_TOPGEN]) == tg, bar);
            __builtin_amdgcn_fence(__ATOMIC_ACQUIRE, "agent");
            xb_add(&bar[XB_XGEN(b.x)], 1u);
            asm volatile("s_waitcnt vmcnt(0)" ::: "memory");
        } else {
            XB_SPIN(xb_ld(&bar[XB_XGEN(b.x)]) == gen, bar);
            __builtin_amdgcn_fence(__ATOMIC_ACQUIRE, "agent");
            asm volatile("s_waitcnt vmcnt(0)" ::: "memory");
        }
    }
    __syncthreads();
}

constexpr int N_CNT = 32 + 256;
__device__ __forceinline__ unsigned* cnt_word(unsigned char* ws, int layer, int kind, int panel) { return (unsigned*)(ws + WS_BAR) + XCD_BAR_WORDS + ((layer * 2 + kind) * 4 + panel) * 64; }
__device__ __forceinline__ unsigned* pcnt_word(unsigned char* ws, int layer, int pm) { return (unsigned*)(ws + WS_BAR) + XCD_BAR_WORDS + (32 + layer * 64 + pm) * 64; }
__device__ __forceinline__ void st_wt64(void* p, u32x2 w) { __hip_atomic_store((unsigned long long*)p, (unsigned long long)w.x | ((unsigned long long)w.y << 32), __ATOMIC_RELAXED, __HIP_MEMORY_SCOPE_AGENT); }
__device__ __forceinline__ void wait_count(unsigned* word, unsigned need, unsigned* tmo) {
    if (threadIdx.x == 0) {
        unsigned sp = 0;
        while (xb_ld(word) < need) { __builtin_amdgcn_s_sleep(2); if ((++sp & 255u) == 0u) { if (xb_ld(tmo)) break; if (sp > XB_SPIN_CAP) { atomicAdd(tmo, 1u); break; } } }
        __builtin_amdgcn_fence(__ATOMIC_ACQUIRE, "agent");
        asm volatile("s_waitcnt vmcnt(0)" ::: "memory");
    }
    __syncthreads();
}

namespace pg8 {
constexpr int BM = 256, BK = 64, HALF = 128, HTB = HALF * BK * 2, NXCD = 8, WGM = 8;
__device__ __forceinline__ int lds_byte(int r, int c) { const int st = (r >> 4) * 2 + (c >> 5), rr = r & 15, cc = c & 31, ob = rr * 64 + cc * 2; return st * 1024 + (ob ^ (((ob >> 9) & 1) << 5)); }
__device__ __forceinline__ void stage_rc(int b, int& R, int& C) { const int st = b / 1024, sb = b % 1024, swz = sb ^ (((sb >> 9) & 1) << 5); R = (st >> 1) * 16 + swz / 64; C = (st & 1) * 32 + (swz % 64) / 2; }
__device__ __forceinline__ int perm32(int rho) { const int n = rho >> 4, i = rho & 15; return 8 * (i >> 2) + 4 * n + (i & 3); }
struct Unit { int pm, pn; };
struct Gemm { const bf16_t* A; const bf16_t* Bt; int M, N, K; };
struct StaticOrder {
    int nM, nN, nwg, G, c;
    __device__ __forceinline__ void init(int M, int N, int G_, int c_) { nM = M / BM; nN = N / BM; nwg = nM * nN; G = G_; c = c_; }
    __device__ __forceinline__ void map(int L, Unit& u) const {
        int wgid = L; { const int q = nwg / NXCD, r = nwg % NXCD, xcd = wgid % NXCD, off = wgid / NXCD; wgid = (xcd < r ? xcd * (q + 1) : r * (q + 1) + (xcd - r) * q) + off; }
        const int nig = WGM * nN, gid = wgid / nig, fm = gid * WGM, gsz = (nM - fm) < WGM ? (nM - fm) : WGM;
        u.pm = fm + ((wgid % nig) % gsz); u.pn = (wgid % nig) / gsz;
    }
    __device__ __forceinline__ bool next(int i, Unit& u) const { const long L = (long)i * G + c; if (L >= nwg) return false; map((int)L, u); return true; }
};
struct OneUnit { int pm, pn; __device__ __forceinline__ bool next(int i, Unit& u) const { if (i) return false; u.pm = pm; u.pn = pn; return true; } };
struct COrder {
    StaticOrder so; int c, seg;
    __device__ __forceinline__ bool next(int i, Unit& u) const {
        if (c < 128) { if (i > 5) return false; so.map(i * 256 + c, u); return true; }
        if (c < 216) { if (i > 5) return false; if (i == 0) { const int su = c - 128; u.pm = 64 + su / 22; u.pn = su % 22; return true; } so.map((i - 1) * 256 + c, u); return true; }
        if (c < 232) { if (i > 5) return false; so.map(i < 5 ? i * 256 + c : 1024 + 240 + (c - 216), u); return true; }
        if (c < 240) { if (i > 4) return false; so.map(i * 256 + c, u); return true; }
        if (seg == 0) { if (i > 0) return false; so.map(c, u); return true; }
        if (i > 2) return false; so.map((i + 1) * 256 + c, u); return true;
    }
};

template <class Epi, class Sched>
__device__ __forceinline__ void gemm_phase(LAS unsigned char* lds, const Gemm g, const Sched& S, const Epi& E) {
    const int tid = opaque_tid(), wid = __builtin_amdgcn_readfirstlane(tid >> 6), lane = tid & 63, wr = wid >> 2, wc = wid & 3, fr = lane & 15, fq = lane >> 4;
    const int K = g.K, nt = K / BK;
    unsigned voffA[2], voffB[2];
#pragma unroll
    for (int i = 0; i < 2; ++i) { int R, C; stage_rc(tid * 16 + i * 8192, R, C); const int Rb = (R & ~31) + perm32(R & 31);
        const int Ra = Epi::AROWPERM ? (8 * (16 * (R >> 6) + (R & 15)) + ((R >> 4) & 3)) : R;
        voffA[i] = (unsigned)(Ra * K + C) * 2u; voffB[i] = (unsigned)(Rb * K + C) * 2u; }
    const size_t kstep = (size_t)(BK * 2);
    const size_t hstepB = (size_t)HALF * K * 2;
    const size_t hstepA = Epi::AROWPERM ? (size_t)4 * K * 2 : hstepB;
    const size_t tstep = 2 * hstepB;
    const unsigned ldsw = (unsigned)wid * 1024u;
    const int aoff = lds_byte(wr * 64 + fr, fq * 8), boff = lds_byte(wc * 32 + fr, fq * 8);
#define PG8_SA(b, h) (((b) * 2 + (h)) * HTB)
#define PG8_SB(b, h) ((4 + (b) * 2 + (h)) * HTB)
#define PG8_STAGE(bufoff, gbase, voff) do { _Pragma("unroll") for (int _i = 0; _i < 2; ++_i) \
        __builtin_amdgcn_global_load_lds((const unsigned*)((const char*)(gbase) + (voff)[_i]), (LAS unsigned*)(lds + (bufoff) + ldsw + _i * 8192), 16, 0, 0); } while (0)
#define PG8_LDA(dst, b, h) do { _Pragma("unroll") for (int m = 0; m < 4; ++m) _Pragma("unroll") for (int k = 0; k < 2; ++k) dst[m][k] = *(const LAS bf16x8*)(lds + PG8_SA(b, h) + aoff + m * 2048 + k * 1024); } while (0)
#define PG8_LDB(dst, b, h) do { _Pragma("unroll") for (int n = 0; n < 2; ++n) _Pragma("unroll") for (int k = 0; k < 2; ++k) dst[n][k] = *(const LAS bf16x8*)(lds + PG8_SB(b, h) + boff + n * 2048 + k * 1024); } while (0)
#define PG8_MMA(ai, bj, At, Bt) do { __builtin_amdgcn_s_setprio(1); _Pragma("unroll") for (int m = 0; m < 4; ++m) _Pragma("unroll") for (int n = 0; n < 2; ++n) _Pragma("unroll") for (int k = 0; k < 2; ++k) \
        acc[ai][bj][m][n] = __builtin_amdgcn_mfma_f32_16x16x32_bf16(Bt[n][k], At[m][k], acc[ai][bj][m][n], 0, 0, 0); __builtin_amdgcn_s_setprio(0); } while (0)
#define PG8_WAIT_V(n) asm volatile("s_waitcnt vmcnt(" #n ")" ::: "memory")
#define PG8_WAIT_L(n) asm volatile("s_waitcnt lgkmcnt(" #n ")" ::: "memory")
#define PG8_BAR __builtin_amdgcn_s_barrier()
#define PG8_SCHED __builtin_amdgcn_sched_barrier(0)
    Unit cur, nxt; int ui = 0;
    if (!S.next(0, cur)) return;
    f32x4 acc[2][2][4][2];
    typename Epi::Raw raw;
    if constexpr (Epi::HAS_INIT) E.load_init(raw, cur, wr, wc);
    bf16x8 At[4][2], B0[2][2], B1[2][2];
    const char* cA = (const char*)g.A + (size_t)cur.pm * tstep; const char* cB = (const char*)g.Bt + (size_t)cur.pn * tstep;
    PG8_STAGE(PG8_SB(0, 0), cB, voffB); PG8_STAGE(PG8_SA(0, 0), cA, voffA); PG8_STAGE(PG8_SB(0, 1), cB + hstepB, voffB); PG8_STAGE(PG8_SA(0, 1), cA + hstepA, voffA);
    if (wr == 1) PG8_BAR;
    PG8_WAIT_V(4); PG8_BAR;
    PG8_STAGE(PG8_SB(1, 0), cB + kstep, voffB); PG8_STAGE(PG8_SA(1, 0), cA + kstep, voffA); PG8_STAGE(PG8_SB(1, 1), cB + hstepB + kstep, voffB);
    PG8_WAIT_V(6); PG8_BAR;
    if constexpr (Epi::HAS_INIT) E.apply_init(acc, raw);
    else {
#pragma unroll
        for (int a = 0; a < 2; ++a)
#pragma unroll
            for (int b = 0; b < 2; ++b)
#pragma unroll
                for (int m = 0; m < 4; ++m)
#pragma unroll
                    for (int n = 0; n < 2; ++n) acc[a][b][m][n] = (f32x4){0.f, 0.f, 0.f, 0.f};
    }
    for (;;) {
        const bool has_next = S.next(ui + 1, nxt);
        const char* nA = has_next ? (const char*)g.A + (size_t)nxt.pm * tstep : cA; const char* nB = has_next ? (const char*)g.Bt + (size_t)nxt.pn * tstep : cB;
        for (int t = 0; t < nt; t += 2) {
            const bool last = (t == nt - 2);
            const char* a1 = cA + (size_t)(t + 1) * kstep;
            const char* a2 = last ? nA : cA + (size_t)(t + 2) * kstep; const char* b2 = last ? nB : cB + (size_t)(t + 2) * kstep;
            const char* a3 = a2 + kstep; const char* b3 = b2 + kstep;
            PG8_LDB(B0, 0, 0); PG8_SCHED; PG8_LDA(At, 0, 0); PG8_STAGE(PG8_SA(1, 1), a1 + hstepA, voffA);
            PG8_WAIT_L(8); PG8_BAR; PG8_WAIT_L(0); PG8_MMA(0, 0, At, B0); PG8_BAR; PG8_SCHED;
            PG8_LDB(B1, 0, 1); PG8_STAGE(PG8_SB(0, 0), b2, voffB);
            PG8_BAR; PG8_WAIT_L(0); PG8_MMA(0, 1, At, B1); PG8_BAR;
            PG8_LDA(At, 0, 1); PG8_STAGE(PG8_SA(0, 0), a2, voffA);
            PG8_BAR; PG8_WAIT_L(0); PG8_MMA(1, 0, At, B0); PG8_BAR; PG8_SCHED;
            PG8_STAGE(PG8_SB(0, 1), b2 + hstepB, voffB);
            PG8_WAIT_V(6); PG8_BAR; PG8_MMA(1, 1, At, B1); PG8_BAR;
            PG8_LDB(B0, 1, 0); PG8_SCHED; PG8_LDA(At, 1, 0); PG8_STAGE(PG8_SA(0, 1), a2 + hstepA, voffA);
            PG8_WAIT_L(8); PG8_BAR; PG8_WAIT_L(0); PG8_MMA(0, 0, At, B0); PG8_BAR; PG8_SCHED;
            PG8_LDB(B1, 1, 1); PG8_STAGE(PG8_SB(1, 0), b3, voffB);
            PG8_BAR; PG8_WAIT_L(0); PG8_MMA(0, 1, At, B1); PG8_BAR;
            PG8_LDA(At, 1, 1); PG8_STAGE(PG8_SA(1, 0), a3, voffA);
            PG8_BAR; PG8_WAIT_L(0); PG8_MMA(1, 0, At, B0); PG8_BAR; PG8_SCHED;
            PG8_STAGE(PG8_SB(1, 1), b3 + hstepB, voffB);
            PG8_WAIT_V(6); PG8_BAR; PG8_MMA(1, 1, At, B1); PG8_BAR;
        }
        E(acc, cur, wr, wc, fr, fq);
        if (!has_next) break;
        if constexpr (Epi::HAS_INIT) { E.load_init(raw, nxt, wr, wc); E.apply_init(acc, raw); }
        else {
#pragma unroll
            for (int a = 0; a < 2; ++a)
#pragma unroll
                for (int b = 0; b < 2; ++b)
#pragma unroll
                    for (int m = 0; m < 4; ++m)
#pragma unroll
                        for (int n = 0; n < 2; ++n) acc[a][b][m][n] = (f32x4){0.f, 0.f, 0.f, 0.f};
        }
        cur = nxt; cA = nA; cB = nB; ++ui;
    }
    PG8_WAIT_V(0);
    if (wr == 0) PG8_BAR;
    PG8_BAR;
#undef PG8_SA
#undef PG8_SB
#undef PG8_STAGE
#undef PG8_LDA
#undef PG8_LDB
#undef PG8_MMA
#undef PG8_WAIT_V
#undef PG8_WAIT_L
#undef PG8_BAR
#undef PG8_SCHED
}
}

struct NoRaw {};
struct EpiA {
    static constexpr bool AROWPERM = false, HAS_INIT = false; typedef NoRaw Raw;
    const float* ss1; bf16_t* zp; float* vss; float* poolP; float* poolS;
    __device__ __forceinline__ void operator()(const f32x4 (&acc)[2][2][4][2], const pg8::Unit& u, int wr, int wc, int fr_, int fq_) const {
        const int lane_ = opaque_tid() & 63, fr = lane_ & 15, fq = lane_ >> 4;
        const int row0 = u.pm * 256 + wr * 64 + fr;
        const int kind = u.pn >> 1;
        const int colt = (u.pn & 1) * 256 + wc * 32 + 8 * fq;
        bf16_t* base = zp + (size_t)kind * ((size_t)MT * 512);
        float my0, my1;
        { const int k0 = 2 * fq, k1 = k0 + 1;
          my0 = rsqrtf(sum16(ss1 + (size_t)(row0 + 128 * (k0 >> 2) + 16 * (k0 & 3)) * 16) * (1.0f / 1024.0f) + EPS);
          my1 = rsqrtf(sum16(ss1 + (size_t)(row0 + 128 * (k1 >> 2) + 16 * (k1 & 3)) * 16) * (1.0f / 1024.0f) + EPS); }
        float rsv[8];
#pragma unroll
        for (int k = 0; k < 8; ++k) rsv[k] = __shfl((k & 1) ? my1 : my0, (k >> 1) * 16 + fr);
#pragma unroll
        for (int ai = 0; ai < 2; ++ai)
#pragma unroll
            for (int m = 0; m < 4; ++m) {
                const int row = row0 + ai * 128 + m * 16;
                const float rs = rsv[ai * 4 + m];
                float ssum = 0.f;
#pragma unroll
                for (int bj = 0; bj < 2; ++bj) {
                    f32x4 v0 = acc[ai][bj][m][0] * rs, v1 = acc[ai][bj][m][1] * rs;
                    const int col = colt + bj * 128;
                    if (kind == 0) {
                        if (row < MP) { const int t = row & 2047; if (t >= 2033) { float* o = poolP + ((size_t)(row >> 11) * 15 + (t - 2033)) * 512 + col; *(f32x4*)o = v0; *(f32x4*)(o + 4) = v1; } }
                        else { const int rr = row - MP; float* o = poolS + ((size_t)(rr >> 3) * 15 + 7 + (rr & 7)) * 512 + col; *(f32x4*)o = v0; *(f32x4*)(o + 4) = v1; }
                    } else {
                        v0 = gelu4(v0); v1 = gelu4(v1);
                        if (kind == 2) ssum += (v0[0] * v0[0] + v0[1] * v0[1]) + (v0[2] * v0[2] + v0[3] * v0[3]) + (v1[0] * v1[0] + v1[1] * v1[1]) + (v1[2] * v1[2] + v1[3] * v1[3]);
                    }
                    u32x4 w; w.x = cvt_pk_bf16(v0[0], v0[1]); w.y = cvt_pk_bf16(v0[2], v0[3]); w.z = cvt_pk_bf16(v1[0], v1[1]); w.w = cvt_pk_bf16(v1[2], v1[3]);
                    *(u32x4*)(base + (size_t)row * 512 + col) = w;
                }
                if (kind == 2) { ssum += __shfl_xor(ssum, 16); ssum += __shfl_xor(ssum, 32); if (fq == 0) vss[(size_t)row * 8 + (u.pn & 1) * 4 + wc] = ssum; }
            }
    }
};
template <bool FROM_IN> struct EpiX {
    static constexpr bool AROWPERM = false, HAS_INIT = !FROM_IN;
    struct Raw { u32x4 r[2][4][2]; };
    const float* xin_p; const float* xin_s; bf16_t* xb; float* ssout;
    __device__ __forceinline__ void load_init(Raw& raw, const pg8::Unit& u, int wr, int wc) const {
        const int lane_ = opaque_tid() & 63, fr = lane_ & 15, fq = lane_ >> 4;
        const bf16_t* p = xb + (size_t)(u.pm * 256 + wr * 64 + fr) * D + u.pn * 256 + wc * 32 + 8 * fq;
#pragma unroll
        for (int ai = 0; ai < 2; ++ai)
#pragma unroll
            for (int m = 0; m < 4; ++m)
#pragma unroll
                for (int bj = 0; bj < 2; ++bj) raw.r[ai][m][bj] = *(const u32x4*)(p + (size_t)(ai * 128 + m * 16) * D + bj * 128);
    }
    __device__ __forceinline__ void apply_init(f32x4 (&acc)[2][2][4][2], const Raw& raw) const {
#pragma unroll
        for (int ai = 0; ai < 2; ++ai)
#pragma unroll
            for (int m = 0; m < 4; ++m)
#pragma unroll
                for (int bj = 0; bj < 2; ++bj) {
                    const u32x4 r = raw.r[ai][m][bj]; acc[ai][bj][m][0] = (f32x4){bflo(r.x), bfhi(r.x), bflo(r.y), bfhi(r.y)}; acc[ai][bj][m][1] = (f32x4){bflo(r.z), bfhi(r.z), bflo(r.w), bfhi(r.w)};
                }
    }
    __device__ __forceinline__ void operator()(const f32x4 (&acc)[2][2][4][2], const pg8::Unit& u, int wr, int wc, int fr_, int fq_) const {
        const int lane_ = opaque_tid() & 63, fr = lane_ & 15, fq = lane_ >> 4;
        const int row0 = u.pm * 256 + wr * 64 + fr, col0 = u.pn * 256 + wc * 32 + 8 * fq;
#pragma unroll
        for (int ai = 0; ai < 2; ++ai)
#pragma unroll
            for (int m = 0; m < 4; ++m) {
                const int row = row0 + ai * 128 + m * 16;
                float ssum = 0.f;
#pragma unroll
                for (int bj = 0; bj < 2; ++bj) {
                    const int col = col0 + bj * 128;
                    f32x4 v0 = acc[ai][bj][m][0], v1 = acc[ai][bj][m][1];
                    if constexpr (FROM_IN) { const float* xo = row < MP ? xin_p + (size_t)row * D : xin_s + (size_t)(row - MP) * D; v0 += *(const f32x4*)(xo + col); v1 += *(const f32x4*)(xo + col + 4); }
                    ssum += (v0[0] * v0[0] + v0[1] * v0[1]) + (v0[2] * v0[2] + v0[3] * v0[3]) + (v1[0] * v1[0] + v1[1] * v1[1]) + (v1[2] * v1[2] + v1[3] * v1[3]);
                    u32x4 w; w.x = cvt_pk_bf16(v0[0], v0[1]); w.y = cvt_pk_bf16(v0[2], v0[3]); w.z = cvt_pk_bf16(v1[0], v1[1]); w.w = cvt_pk_bf16(v1[2], v1[3]);
                    *(u32x4*)(xb + (size_t)row * D + col) = w;
                }
                ssum += __shfl_xor(ssum, 16); ssum += __shfl_xor(ssum, 32); if (fq == 0) ssout[(size_t)row * 16 + u.pn * 4 + wc] = ssum;
            }
    }
};
struct EpiC {
    static constexpr bool AROWPERM = true, HAS_INIT = false; typedef NoRaw Raw;
    const float* ss2; const float* cw; const float* cb; const float* sconv; bf16_t* act; float* halo; float* fix; float* convP; float* convS; unsigned* actcnt;
    __device__ __forceinline__ void operator()(const f32x4 (&acc)[2][2][4][2], const pg8::Unit& u, int wr, int wc, int fr_, int fq_) const {
        const int lane_ = opaque_tid() & 63, fr = lane_ & 15, fq = lane_ >> 4;
        const int q = 16 * wr + fr;
        const int tok0 = u.pm * 256 + 8 * q;
        const bool sample = (u.pm * 256) >= MP;
        const float my0 = rsqrtf(sum16(ss2 + (size_t)(tok0 + 2 * fq) * 16) * (1.0f / 1024.0f) + EPS), my1 = rsqrtf(sum16(ss2 + (size_t)(tok0 + 2 * fq + 1) * 16) * (1.0f / 1024.0f) + EPS);
        float rs[8];
#pragma unroll
        for (int k = 0; k < 8; ++k) rs[k] = __shfl((k & 1) ? my1 : my0, (k >> 1) * 16 + fr);
        const int cgl = u.pn * 128 + wc * 32 + 8 * fq;
        const bool first = (fr == 0), lastl = (fr == 15);
        const int bidx = 2 * u.pm + wr;
        const bool seqstart = (bidx & 15) == 0;
        const bool deferred = !sample && first && !seqstart;
        const int sb = sample ? ((tok0 - MP) >> 3) : 0;
#pragma unroll
        for (int n = 0; n < 2; ++n) {
            const int c = cgl + 4 * n;
            const f32x4 w0 = *(const f32x4*)(cw + c), w1 = *(const f32x4*)(cw + FF + c), w2 = *(const f32x4*)(cw + 2 * FF + c), bb = *(const f32x4*)(cb + c);
            const f32x4 g6 = acc[1][0][2][n] * rs[6], g7 = acc[1][0][3][n] * rs[7];
            f32x4 gm1, gm2;
            if (sample) { gm2 = *(const f32x4*)(sconv + ((size_t)sb * 2 + 0) * FF + c); gm1 = *(const f32x4*)(sconv + ((size_t)sb * 2 + 1) * FF + c); }
            else {
#pragma unroll
                for (int j = 0; j < 4; ++j) { gm1[j] = __shfl_up(g7[j], 1, 16); gm2[j] = __shfl_up(g6[j], 1, 16); }
                if (first) { gm1 = (f32x4){0.f, 0.f, 0.f, 0.f}; gm2 = gm1; }
            }
#pragma unroll
            for (int k = 0; k < 8; ++k) {
                const f32x4 gk = acc[k >> 2][0][k & 3][n] * rs[k], uk = acc[k >> 2][1][k & 3][n] * rs[k];
                const f32x4 cv = bb + w0 * gm2 + w1 * gm1 + w2 * gk;
                const f32x4 a = gelu4(cv) * uk;
                if (!(deferred && k < 2)) { u32x2 w; w.x = cvt_pk_bf16(a[0], a[1]); w.y = cvt_pk_bf16(a[2], a[3]); if (sample) st_wt64(act + (size_t)(tok0 + k) * FF + c, w); else *(u32x2*)(act + (size_t)(tok0 + k) * FF + c) = w; }
                if (k < 2 && deferred) { float* o = fix + (((size_t)bidx * 2 + k) * FF + c) * 2;
                    *(f32x4*)o = (f32x4){gk[0], uk[0], gk[1], uk[1]}; *(f32x4*)(o + 4) = (f32x4){gk[2], uk[2], gk[3], uk[3]}; }
                gm2 = gm1; gm1 = gk;
            }
            if (!sample) {
                if (lastl) {
                    const int hb = bidx + 1;
                    *(f32x4*)(halo + ((size_t)hb * 2 + 0) * FF + c) = g6; *(f32x4*)(halo + ((size_t)hb * 2 + 1) * FF + c) = g7;
                    if ((hb & 15) == 0) { const int b = (hb >> 4) - 1; *(f32x4*)(convP + ((size_t)b * 2 + 0) * FF + c) = g6; *(f32x4*)(convP + ((size_t)b * 2 + 1) * FF + c) = g7; }
                }
            } else { *(f32x4*)(convS + ((size_t)sb * 2 + 0) * FF + c) = g6; *(f32x4*)(convS + ((size_t)sb * 2 + 1) * FF + c) = g7; }
        }
        if (sample) { asm volatile("s_waitcnt vmcnt(0)" ::: "memory"); if (lane_ == 0) xb_add(actcnt + (u.pm - 64) * 64, 1u); }
    }
};

struct TDesc { const float* W; const float* gk; const float* gn; bf16_t* WT; int N, ldk, dst_row0, k0, n0; };
struct TRegs { f32x4 v[8]; };
__device__ __forceinline__ void t_load(const TDesc& d, TRegs& t, int lane) {
    const int c4 = lane & 7;
    f32x4 gnv = (f32x4){1.f, 1.f, 1.f, 1.f};
    if (d.gn) gnv = *(const f32x4*)(d.gn + d.n0 + 4 * c4);
#pragma unroll
    for (int i = 0; i < 8; ++i) { const int kk = 8 * i + (lane >> 3); f32x4 v = *(const f32x4*)(d.W + (size_t)(d.k0 + kk) * d.N + d.n0 + 4 * c4) * gnv; if (d.gk) v *= d.gk[d.k0 + kk]; t.v[i] = v; }
}
__device__ __forceinline__ void t_store(const TDesc& d, const TRegs& t, LAS float* scr, int lane) {
    const int c4 = lane & 7;
#pragma unroll
    for (int i = 0; i < 8; ++i) { const int kk = 8 * i + (lane >> 3); LAS float* q = scr + kk * 33 + 4 * c4; q[0] = t.v[i][0]; q[1] = t.v[i][1]; q[2] = t.v[i][2]; q[3] = t.v[i][3]; }
    asm volatile("s_waitcnt lgkmcnt(0)" ::: "memory");
    const int c = lane & 7;
#pragma unroll
    for (int j = 0; j < 4; ++j) { const int n = (lane >> 3) + 8 * j; const LAS float* sp = scr + (8 * c) * 33 + n;
        u32x4 o; o.x = cvt_pk_bf16(sp[0 * 33], sp[1 * 33]); o.y = cvt_pk_bf16(sp[2 * 33], sp[3 * 33]); o.z = cvt_pk_bf16(sp[4 * 33], sp[5 * 33]); o.w = cvt_pk_bf16(sp[6 * 33], sp[7 * 33]);
        *(u32x4*)(d.WT + (size_t)(d.dst_row0 + n) * d.ldk + d.k0 + 8 * c) = o; }
    asm volatile("s_waitcnt lgkmcnt(0)" ::: "memory");
}
__device__ __forceinline__ void t_decode(const Params& P, int it, TDesc& d) {
    const int l = it / 5536; int r = it % 5536;
    d.gk = nullptr; d.gn = nullptr;
    if (r < 768) { const int kb = r / 48, nb = r % 48; d.W = P.in[I_WIN] + (size_t)l * D * INW; d.N = INW; d.gk = P.in[I_N1G] + l * D; d.WT = (bf16_t*)(P.ws + WS_WIN) + (size_t)l * INW * D; d.ldk = D; d.dst_row0 = 32 * nb; d.k0 = 64 * kb; d.n0 = 32 * nb; return; } r -= 768;
    if (r < 512) { const int kb = r / 32, nb = r % 32; d.W = P.in[I_WOUT] + (size_t)l * D * D; d.N = D; d.WT = (bf16_t*)(P.ws + WS_WOUT) + (size_t)l * D * D; d.ldk = D; d.dst_row0 = 32 * nb; d.k0 = 64 * kb; d.n0 = 32 * nb; return; } r -= 512;
    if (r < 2816) { const int up = r >= 1408; if (up) r -= 1408; const int kb = r / 88, nb = r % 88, n0 = 32 * nb; d.W = (up ? P.in[I_WUP] : P.in[I_WGATE]) + (size_t)l * D * FF; d.N = FF; d.gk = P.in[I_N2G] + l * D;
        d.WT = (bf16_t*)(P.ws + WS_WGU) + (size_t)l * NGU * D; d.ldk = D; d.dst_row0 = 256 * (n0 >> 7) + 128 * up + (n0 & 127); d.k0 = 64 * kb; d.n0 = n0; return; } r -= 2816;
    if (r < 1408) { const int kb = r / 32, nb = r % 32; d.W = P.in[I_WDOWN] + (size_t)l * FF * D; d.N = D; d.WT = (bf16_t*)(P.ws + WS_WDN) + (size_t)l * D * FF; d.ldk = FF; d.dst_row0 = 32 * nb; d.k0 = 64 * kb; d.n0 = 32 * nb; return; } r -= 1408;
    { const int gi = r >> 3, rr = r & 7, kb = rr >> 2, nb = rr & 3; d.W = P.in[I_POOLW] + (size_t)(l * 4 + gi) * 16384; d.N = 128; d.gn = P.in[I_PSCALE] + l * 512 + gi * 128;
      d.WT = (bf16_t*)(P.ws + WS_PWT) + (size_t)(l * 4 + gi) * 16384; d.ldk = 128; d.dst_row0 = 32 * nb; d.k0 = 64 * kb; d.n0 = 32 * nb; }
}

__device__ __forceinline__ void convert_weights(const Params& P, LAS unsigned char* lds, int layer, int lo, int hi, int gw, int NGW) {
    const int tid = opaque_tid(), lane = tid & 63, wid = tid >> 6;
    LAS float* scr = (LAS float*)(lds + wid * 8704);
    const int base = layer * 5536;
    int it = lo + gw;
    TDesc dc, dn; TRegs tc, tn;
    if (it < hi) { t_decode(P, base + it, dc); t_load(dc, tc, lane); }
    while (it < hi) {
        const int itn = it + NGW; const bool hn = itn < hi;
        if (hn) { t_decode(P, base + itn, dn); t_load(dn, tn, lane); }
        t_store(dc, tc, scr, lane);
        if (hn) { dc = dn; tc = tn; }
        it = itn;
    }
}

__device__ __forceinline__ void phase0(const Params& P, LAS unsigned char* lds) {
    const int tid = opaque_tid(), lane = tid & 63, wid = tid >> 6;
    const int gw = blockIdx.x * 8 + wid, NGW = gridDim.x * 8;
    const int gtid = blockIdx.x * 512 + tid, NT = gridDim.x * 512;
    float* stat = (float*)(P.ws + WS_STAT);
    bf16_t* xb = (bf16_t*)(P.ws + WS_XB);
    for (int row = gw; row < MT; row += NGW) {
        const float* xr = row < MP ? P.in[I_XP] + (size_t)row * D : P.in[I_XS] + (size_t)(row - MP) * D;
        f32x4 v[4]; float s = 0.f;
#pragma unroll
        for (int j = 0; j < 4; ++j) { v[j] = ((const f32x4*)xr)[lane + 64 * j]; s += (v[j][0] * v[j][0] + v[j][1] * v[j][1]) + (v[j][2] * v[j][2] + v[j][3] * v[j][3]); }
        s = wave_sum(s);
#pragma unroll
        for (int j = 0; j < 4; ++j) { u32x2 w; w.x = cvt_pk_bf16(v[j][0], v[j][1]); w.y = cvt_pk_bf16(v[j][2], v[j][3]); ((u32x2*)(xb + (size_t)row * D))[lane + 64 * j] = w; }
        if (lane < 16) stat[(size_t)row * 16 + lane] = lane == 0 ? s : 0.f;
    }
    convert_weights(P, lds, 0, 0, 768, gw, NGW);
    { const f32x4* sp = (const f32x4*)P.in[I_SPOOL]; f32x4* o = (f32x4*)(P.out + O_POOLS);
      for (int i = gtid; i < 4 * 128 * 7 * 128; i += NT) { const int c4 = i & 127, rr = (i >> 7) % 7, lb = (i >> 7) / 7; o[((size_t)lb * 15 + rr) * 128 + c4] = sp[((size_t)lb * 15 + rr + 8) * 128 + c4]; } }
    { bf16_t* WSB = (bf16_t*)(P.ws + WS_WSB); const float* wsp = P.in[I_WSP];
      for (int i = gtid; i < 4 * 4 * 128 * 128; i += NT) { const int s = i & 127, t = (i >> 7) & 127; WSB[i] = (s <= t) ? f2bf(wsp[i]) : (bf16_t)0; } }
}

constexpr int MLD = 136;
template <int W> __device__ __forceinline__ void pool_sample_stage(const Params& P, int layer, int gi, int tt, LAS bf16_t* sA, int tid) {
    const bf16_t* ZP = (const bf16_t*)(P.ws + WS_R1 + R1_ZP);
    const int r0 = tt * 128;
    for (int pi = tid; pi < 2048; pi += 512) {
        const int c = pi & 127, bl = pi >> 7; const int b = (tt - 128) * 16 + bl;
        const float* sp = P.in[I_SPOOL] + (((size_t)layer * 128 + b) * 15) * 512 + 128 * gi + c;
        float full[23];
#pragma unroll
        for (int i = 0; i < 15; ++i) full[i] = (i >= 16 - W) ? sp[(size_t)i * 512] : 0.f;
        const bf16_t* zp = ZP + (size_t)(r0 + bl * 8) * 512 + 128 * gi + c;
#pragma unroll
        for (int t = 0; t < 8; ++t) full[15 + t] = bf2f(zp[(size_t)t * 512]);
#pragma unroll
        for (int t = 0; t < 8; ++t) { float s = 0.f;
#pragma unroll
            for (int i = 0; i < W; ++i) s += full[15 + t - i];
            sA[(bl * 8 + t) * MLD + c] = f2bf(s * (1.0f / W) - full[15 + t]); }
    }
}

__device__ __forceinline__ void mixer_phase(const Params& P, int layer, LAS unsigned char* lds, int c2, int G2) {
    const int tid = opaque_tid(), lane = tid & 63, wid = tid >> 6;
    LAS bf16_t* sA = (LAS bf16_t*)lds;
    LAS bf16_t* sB = (LAS bf16_t*)(lds + 34816);
    LAS bf16_t* sP = (LAS bf16_t*)(lds + 69632);
    const bf16_t* ZP = (const bf16_t*)(P.ws + WS_R1 + R1_ZP); const bf16_t* ZU = (const bf16_t*)(P.ws + WS_R1 + R1_ZU); const bf16_t* ZV = (const bf16_t*)(P.ws + WS_R1 + R1_ZV);
    bf16_t* MIX = (bf16_t*)(P.ws + WS_R1 + R1_MIX);
    const float* vss = (const float*)(P.ws + WS_VSP);
    for (int it2 = c2; it2 < 1088; it2 += G2) {
        const int it = it2 < 64 ? 1024 + it2 : it2 - 64;
        const int tt = it >> 3, j = it & 7, r0 = tt * 128;
        const bool sample = tt >= 128;
        if (j < 4) {
            const int gi = j;
            const bf16_t* pw = (const bf16_t*)(P.ws + WS_PWT) + (size_t)(layer * 4 + gi) * 16384;
            for (int e = tid; e < 2048; e += 512) { const int n = e >> 4, ch = e & 15; *(LAS u32x4*)(sB + n * MLD + ch * 8) = *(const u32x4*)(pw + n * 128 + ch * 8); }
            if (!sample) {
                const bf16_t* zp = ZP + 128 * gi;
                for (int e = tid; e < 143 * 16; e += 512) { const int row = e >> 4, ch = e & 15; const int grow = r0 - 15 + row; u32x4 v = (u32x4){0u, 0u, 0u, 0u};
                    if (row >= 15 || (tt & 15) != 0) v = *(const u32x4*)(zp + (size_t)grow * 512 + ch * 8);
                    *(LAS u32x4*)(sP + row * 128 + ch * 8) = v; }
                __syncthreads();
                const int ch = tid & 15, seg = tid >> 4; const int w = 2 << gi;
                const int tpos0 = (r0 & 2047) + seg * 4;
                float sm[8];
#pragma unroll
                for (int q = 0; q < 8; ++q) sm[q] = 0.f;
                for (int i = 1; i < w; ++i) { const u32x4 pr = *(const LAS u32x4*)(sP + (15 + seg * 4 - i) * 128 + ch * 8);
                    sm[0] += bflo(pr.x); sm[1] += bfhi(pr.x); sm[2] += bflo(pr.y); sm[3] += bfhi(pr.y); sm[4] += bflo(pr.z); sm[5] += bfhi(pr.z); sm[6] += bflo(pr.w); sm[7] += bfhi(pr.w); }
#pragma unroll
                for (int rr = 0; rr < 4; ++rr) {
                    const int row = seg * 4 + rr;
                    const u32x4 pr = *(const LAS u32x4*)(sP + (15 + row) * 128 + ch * 8);
                    float pv[8] = {bflo(pr.x), bfhi(pr.x), bflo(pr.y), bfhi(pr.y), bflo(pr.z), bfhi(pr.z), bflo(pr.w), bfhi(pr.w)};
                    const float inv = 1.0f / (float)min(tpos0 + rr + 1, w);
                    float dv[8];
#pragma unroll
                    for (int q = 0; q < 8; ++q) { sm[q] += pv[q]; dv[q] = sm[q] * inv - pv[q]; }
                    u32x4 o; o.x = cvt_pk_bf16(dv[0], dv[1]); o.y = cvt_pk_bf16(dv[2], dv[3]); o.z = cvt_pk_bf16(dv[4], dv[5]); o.w = cvt_pk_bf16(dv[6], dv[7]);
                    *(LAS u32x4*)(sA + row * MLD + ch * 8) = o;
                    const u32x4 ps = *(const LAS u32x4*)(sP + (15 + row - w + 1) * 128 + ch * 8);
                    sm[0] -= bflo(ps.x); sm[1] -= bfhi(ps.x); sm[2] -= bflo(ps.y); sm[3] -= bfhi(ps.y); sm[4] -= bflo(ps.z); sm[5] -= bfhi(ps.z); sm[6] -= bflo(ps.w); sm[7] -= bfhi(ps.w);
                }
            } else {
                if (gi == 0) pool_sample_stage<2>(P, layer, gi, tt, sA, tid);
                else if (gi == 1) pool_sample_stage<4>(P, layer, gi, tt, sA, tid);
                else if (gi == 2) pool_sample_stage<8>(P, layer, gi, tt, sA, tid);
                else pool_sample_stage<16>(P, layer, gi, tt, sA, tid);
            }
        } else {
            const int h = j - 4;
            const bf16_t* wsb = (const bf16_t*)(P.ws + WS_WSB) + (size_t)(layer * 4 + h) * 16384;
            if (!sample) { for (int e = tid; e < 2048; e += 512) { const int row = e >> 4, ch = e & 15; *(LAS u32x4*)(sA + row * MLD + ch * 8) = *(const u32x4*)(wsb + row * 128 + ch * 8); } }
            else { for (int e = tid; e < 2048; e += 512) { const int i = e >> 4, ch = e & 15; u32x4 v = (u32x4){0u, 0u, 0u, 0u}; if (ch == (i >> 3)) v = *(const u32x4*)(wsb + (i & 7) * 128); *(LAS u32x4*)(sA + i * MLD + ch * 8) = v; } }
            const bf16_t* zv = ZV + 128 * h; const float* gv = P.in[I_VNG] + layer * 512 + 128 * h;
            for (int e = tid; e < 2048; e += 512) {
                const int s = e >> 4, ch = e & 15, row = r0 + s;
                const u32x4 raw = *(const u32x4*)(zv + (size_t)row * 512 + ch * 8);
                const f32x4 va = *(const f32x4*)(vss + (size_t)row * 8), vb = *(const f32x4*)(vss + (size_t)row * 8 + 4);
                const float rs = rsqrtf((((va[0] + va[1]) + (va[2] + va[3])) + ((vb[0] + vb[1]) + (vb[2] + vb[3]))) * (1.0f / 512.0f) + EPS);
                const f32x4 g0 = *(const f32x4*)(gv + ch * 8), g1 = *(const f32x4*)(gv + ch * 8 + 4);
                f32x4 v0, v1;
                v0[0] = bflo(raw.x) * rs * g0[0]; v0[1] = bfhi(raw.x) * rs * g0[1]; v0[2] = bflo(raw.y) * rs * g0[2]; v0[3] = bfhi(raw.y) * rs * g0[3];
                v1[0] = bflo(raw.z) * rs * g1[0]; v1[1] = bfhi(raw.z) * rs * g1[1]; v1[2] = bflo(raw.w) * rs * g1[2]; v1[3] = bfhi(raw.w) * rs * g1[3];
#pragma unroll
                for (int jj = 0; jj < 4; ++jj) { sB[(ch * 8 + jj) * MLD + s] = f2bf(v0[jj]); sB[(ch * 8 + 4 + jj) * MLD + s] = f2bf(v1[jj]); }
                if (sample) { float* o = P.out + O_VS + ((size_t)layer * 1024 + (row - MP)) * 512 + 128 * h + ch * 8; *(f32x4*)o = v0; *(f32x4*)(o + 4) = v1; }
            }
        }
        __syncthreads();
        f32x4 acc[8];
#pragma unroll
        for (int nb = 0; nb < 8; ++nb) acc[nb] = (f32x4){0.f, 0.f, 0.f, 0.f};
        const int lr = lane & 15, kq = lane >> 4;
#pragma unroll
        for (int ks = 0; ks < 4; ++ks) {
            const bf16x8 a = *(const LAS bf16x8*)(sA + (16 * wid + lr) * MLD + ks * 32 + kq * 8);
#pragma unroll
            for (int nb = 0; nb < 8; ++nb) { const bf16x8 b = *(const LAS bf16x8*)(sB + (16 * nb + lr) * MLD + ks * 32 + kq * 8); acc[nb] = __builtin_amdgcn_mfma_f32_16x16x32_bf16(b, a, acc[nb], 0, 0, 0); }
        }
        const int row = 16 * wid + lr, grow = r0 + row;
        if (j < 4) {
#pragma unroll
            for (int nb = 0; nb < 8; ++nb) { u32x2 w; w.x = cvt_pk_bf16(acc[nb][0], acc[nb][1]); w.y = cvt_pk_bf16(acc[nb][2], acc[nb][3]); bf16_t* o = MIX + (size_t)grow * D + 128 * j + 16 * nb + 4 * kq; if (sample) st_wt64(o, w); else *(u32x2*)o = w; }
        } else {
            const int h = j - 4;
            const float bias = P.in[I_BSP][(layer * 4 + h) * 128 + (sample ? (row & 7) : row)];
#pragma unroll
            for (int nb = 0; nb < 8; ++nb) { const int col = 128 * h + 16 * nb + 4 * kq; const u32x2 uu = *(const u32x2*)(ZU + (size_t)grow * 512 + col);
                u32x2 w; w.x = cvt_pk_bf16(bflo(uu.x) * (acc[nb][0] + bias), bfhi(uu.x) * (acc[nb][1] + bias)); w.y = cvt_pk_bf16(bflo(uu.y) * (acc[nb][2] + bias), bfhi(uu.y) * (acc[nb][3] + bias));
                bf16_t* o = MIX + (size_t)grow * D + 512 + col; if (sample) st_wt64(o, w); else *(u32x2*)o = w; }
        }
        if (sample) asm volatile("s_waitcnt vmcnt(0)" ::: "memory");
        __syncthreads();
        if (sample && tid == 0) xb_add(cnt_word(P.ws, layer, 0, (tt - 128) >> 1), 1u);
    }
}

__device__ __forceinline__ void patch_panel_quarter(const Params& P, int layer, int pm, int pn) {
    const int tid = opaque_tid();
    const float* halo = (const float*)(P.ws + WS_HALO); const float* fix = (const float*)(P.ws + WS_FIX);
    const float* cw = P.in[I_CONVW] + (size_t)layer * 3 * FF; const float* cb = P.in[I_CONVB] + (size_t)layer * FF;
    bf16_t* act = (bf16_t*)(P.ws + WS_R1);
    if (tid < 352) {
        const int b = tid / 176, g4 = tid % 176, bidx = 2 * pm + b, c = 704 * pn + 4 * g4;
        if ((bidx & 15) != 0) {
            const f32x4 h2 = *(const f32x4*)(halo + ((size_t)bidx * 2 + 0) * FF + c), h1 = *(const f32x4*)(halo + ((size_t)bidx * 2 + 1) * FF + c);
            const float* f0 = fix + (((size_t)bidx * 2 + 0) * FF + c) * 2; const float* f1 = fix + (((size_t)bidx * 2 + 1) * FF + c) * 2;
            const f32x4 a0 = *(const f32x4*)f0, a1 = *(const f32x4*)(f0 + 4), b0 = *(const f32x4*)f1, b1 = *(const f32x4*)(f1 + 4);
            const f32x4 g0 = (f32x4){a0[0], a0[2], a1[0], a1[2]}, u0 = (f32x4){a0[1], a0[3], a1[1], a1[3]}, g1 = (f32x4){b0[0], b0[2], b1[0], b1[2]}, u1 = (f32x4){b0[1], b0[3], b1[1], b1[3]};
            const f32x4 w0 = *(const f32x4*)(cw + c), w1 = *(const f32x4*)(cw + FF + c), w2 = *(const f32x4*)(cw + 2 * FF + c), bb = *(const f32x4*)(cb + c);
            const f32x4 r0 = gelu4(bb + w0 * h2 + w1 * h1 + w2 * g0) * u0, r1 = gelu4(bb + w0 * h1 + w1 * g0 + w2 * g1) * u1;
            const size_t T = (size_t)128 * bidx;
            u32x2 o; o.x = cvt_pk_bf16(r0[0], r0[1]); o.y = cvt_pk_bf16(r0[2], r0[3]); st_wt64(act + T * FF + c, o);
            o.x = cvt_pk_bf16(r1[0], r1[1]); o.y = cvt_pk_bf16(r1[2], r1[3]); st_wt64(act + (T + 1) * FF + c, o);
        }
    }
    asm volatile("s_waitcnt vmcnt(0)" ::: "memory");
    __syncthreads();
    if (tid == 0) xb_add(pcnt_word(P.ws, layer, pm), 1u);
    wait_count(pcnt_word(P.ws, layer, pm), 4u, (unsigned*)(P.ws + WS_BAR) + XB_TMO);
}

__device__ __forceinline__ void final_phase(const Params& P) {
    const int tid = opaque_tid(), lane = tid & 63, wid = tid >> 6;
    const int gw = blockIdx.x * 8 + wid, NGW = gridDim.x * 8;
    const float* ssf = (const float*)(P.ws + WS_STAT);
    const f32x4* gf = (const f32x4*)P.in[I_FNG];
    const bf16_t* xb = (const bf16_t*)(P.ws + WS_XB);
    for (int row = gw; row < MT; row += NGW) {
        const float rs = rsqrtf(sum16(ssf + (size_t)row * 16) * (1.0f / 1024.0f) + EPS);
        f32x4* yr = (f32x4*)(P.out + (size_t)row * D);
        const u32x2* xr = (const u32x2*)(xb + (size_t)row * D);
#pragma unroll
        for (int j = 0; j < 4; ++j) { const u32x2 r = xr[lane + 64 * j]; const f32x4 v = (f32x4){bflo(r.x), bfhi(r.x), bflo(r.y), bfhi(r.y)}; yr[lane + 64 * j] = v * rs * gf[lane + 64 * j]; }
    }
}

__global__ __launch_bounds__(512, 2) void fwd_kernel(Params P) {
    extern __shared__ __attribute__((aligned(16))) unsigned char shm[];
    LAS unsigned char* lds = (LAS unsigned char*)shm;
    cg::grid_group grid = cg::this_grid();
    volatile LAS unsigned* xst = (volatile LAS unsigned*)(lds + 131072);
    if (threadIdx.x == 0) { xst[0] = 0u; xst[1] = 0u; }
    __syncthreads();
    const XcdBarrier xb = xcd_barrier_post((unsigned*)(P.ws + WS_BAR), xst);
    phase0(P, lds);
    grid.sync();
    float* stat = (float*)(P.ws + WS_STAT);
    bf16_t* XB = (bf16_t*)(P.ws + WS_XB);
    unsigned char* R1 = P.ws + WS_R1;
#pragma unroll 1
    for (int l = 0; l < 4; ++l) {
        {
            pg8::Gemm g{XB, (const bf16_t*)(P.ws + WS_WIN) + (size_t)l * INW * D, MT, INW, D};
            pg8::StaticOrder S; S.init(MT, INW, (int)gridDim.x, (int)blockIdx.x);
            EpiA E{stat, (bf16_t*)(R1 + R1_ZP), (float*)(P.ws + WS_VSP),
                   P.out + O_POOLP + (size_t)l * 8 * 15 * 512, P.out + O_POOLS + (size_t)l * 128 * 15 * 512};
            pg8::gemm_phase(lds, g, S, E);
            if (l == 0 && blockIdx.x >= 152) convert_weights(P, lds, 0, 768, 5536, ((int)blockIdx.x - 152) * 8 + (opaque_tid() >> 6), ((int)gridDim.x - 152) * 8);
        }
        xcd_barrier(xb);
        unsigned* tmo = (unsigned*)(P.ws + WS_BAR) + XB_TMO;
        if (blockIdx.x < 16) {
            const int panel = blockIdx.x >> 2;
            wait_count(cnt_word(P.ws, l, 0, panel), 16u, tmo);
            pg8::Gemm g{(const bf16_t*)(R1 + R1_MIX), (const bf16_t*)(P.ws + WS_WOUT) + (size_t)l * D * D, MT, D, D};
            pg8::OneUnit S{64 + panel, (int)(blockIdx.x & 3)};
            { EpiX<false> E{P.in[I_XP], P.in[I_XS], XB, stat}; pg8::gemm_phase(lds, g, S, E); }
        } else mixer_phase(P, l, lds, (int)blockIdx.x - 16, (int)gridDim.x - 16);
        xcd_barrier(xb);
        {
            pg8::Gemm g{(const bf16_t*)(R1 + R1_MIX), (const bf16_t*)(P.ws + WS_WOUT) + (size_t)l * D * D, MP, D, D};
            pg8::StaticOrder S; S.init(MP, D, (int)gridDim.x, (int)blockIdx.x);
            { EpiX<false> E{P.in[I_XP], P.in[I_XS], XB, stat}; pg8::gemm_phase(lds, g, S, E); }
        }
        xcd_barrier(xb);
        {
            pg8::Gemm g{XB, (const bf16_t*)(P.ws + WS_WGU) + (size_t)l * NGU * D, MT, NGU, D};
            pg8::COrder S; S.so.init(MP, NGU, 256, 0); S.c = (int)blockIdx.x; S.seg = 0;
            EpiC E{stat, P.in[I_CONVW] + (size_t)l * 3 * FF, P.in[I_CONVB] + (size_t)l * FF, P.in[I_SCONV] + (size_t)l * 128 * 2 * FF,
                   (bf16_t*)R1, (float*)(P.ws + WS_HALO), (float*)(P.ws + WS_FIX), P.out + O_CONVP + (size_t)l * 8 * 2 * FF, P.out + O_CONVS + (size_t)l * 128 * 2 * FF, cnt_word(P.ws, l, 1, 0)};
            pg8::gemm_phase(lds, g, S, E);
            if (l < 3 && blockIdx.x < 240) convert_weights(P, lds, l + 1, 0, 5536, (int)blockIdx.x * 8 + (opaque_tid() >> 6), 240 * 8);
            if (blockIdx.x >= 240) {
                const int su = (int)blockIdx.x - 240, panel = su >> 2;
                wait_count(cnt_word(P.ws, l, 1, panel), 176u, tmo);
                pg8::Gemm gd{(const bf16_t*)R1, (const bf16_t*)(P.ws + WS_WDN) + (size_t)l * D * FF, MT, D, FF};
                pg8::OneUnit Sd{64 + panel, su & 3};
                EpiX<false> Ed{P.in[I_XP], P.in[I_XS], XB, stat};
                pg8::gemm_phase(lds, gd, Sd, Ed);
                S.seg = 1;
                pg8::gemm_phase(lds, g, S, E);
            }
        }
        xcd_barrier(xb);
        {
            pg8::Gemm g{(const bf16_t*)R1, (const bf16_t*)(P.ws + WS_WDN) + (size_t)l * D * FF, MP, D, FF};
            pg8::StaticOrder S; S.init(MP, D, (int)gridDim.x, (int)blockIdx.x);
            { pg8::Unit u0; if (S.next(0, u0)) patch_panel_quarter(P, l, u0.pm, u0.pn); }
            EpiX<false> E{P.in[I_XP], P.in[I_XS], XB, stat};
            pg8::gemm_phase(lds, g, S, E);
        }
        xcd_barrier(xb);
    }
    final_phase(P);
}

extern "C" void kernel_launch(void* const* d_in, const int* in_sizes, int n_in, void* d_out, int out_size, void* d_ws, size_t ws_size, hipStream_t stream) {
    static int grid_blocks = 0;
    if (grid_blocks == 0) {
        if (n_in != 19 || ws_size < WS_END) { fprintf(stderr, "kernel_launch: unexpected n_in %d or ws_size %zu (< %zu)\n", n_in, ws_size, (size_t)WS_END); grid_blocks = -1; return; }
        int dev = 0, cus = 0, per_cu = 0;
        hipGetDevice(&dev);
        hipDeviceGetAttribute(&cus, hipDeviceAttributeMultiprocessorCount, dev);
        if (hipFuncSetAttribute((const void*)fwd_kernel, hipFuncAttributeMaxDynamicSharedMemorySize, LDS_BYTES) != hipSuccess) { fprintf(stderr, "kernel_launch: hipFuncSetAttribute failed\n"); grid_blocks = -1; return; }
        hipOccupancyMaxActiveBlocksPerMultiprocessor(&per_cu, (const void*)fwd_kernel, 512, LDS_BYTES);
        if (per_cu < 1) { fprintf(stderr, "kernel_launch: occupancy query says %d blocks per CU\n", per_cu); per_cu = 1; }
        (void)hipGetLastError();
        grid_blocks = cus * per_cu;
        if (grid_blocks != 256) { fprintf(stderr, "kernel_launch: this build schedules for exactly 256 workgroups, got %d\n", grid_blocks); grid_blocks = 256; }
    }
    if (grid_blocks < 0) return;
    if (hipMemsetAsync((char*)d_ws + WS_BAR, 0, (XCD_BAR_WORDS + N_CNT * 64) * 4, stream) != hipSuccess) { fprintf(stderr, "kernel_launch: memset of barrier words failed\n"); return; }
    Params p{};
    for (int i = 0; i < 19; ++i) p.in[i] = (const float*)d_in[i];
    p.out = (float*)d_out; p.ws = (unsigned char*)d_ws;
    void* args[] = {&p};
    hipError_t e = hipLaunchCooperativeKernel((const void*)fwd_kernel, dim3(grid_blocks), dim3(512), args, LDS_BYTES, stream);
    if (e != hipSuccess) fprintf(stderr, "cooperative launch failed: %s (grid %d)\n", hipGetErrorString(e), grid_blocks);
}
```

```cpp
#include <hip/hip_runtime.h>
#include <hip/hip_cooperative_groups.h>
#include <cstdio>
namespace cg = cooperative_groups;

#define LAS __attribute__((address_space(3)))
typedef unsigned short bf16_t;
typedef short bf16x8 __attribute__((ext_vector_type(8)));
typedef float f32x4 __attribute__((ext_vector_type(4)));
typedef unsigned u32x4 __attribute__((ext_vector_type(4)));
typedef unsigned u32x2 __attribute__((ext_vector_type(2)));

constexpr int D = 1024, MP = 16384, MT = 17408, INW = 1536, FF = 2816, NGU = 5632;
constexpr float EPS = 1e-6f;

constexpr size_t O_POOLP = 17825792, O_POOLS = 18071552, O_CONVP = 22003712, O_CONVS = 22183936, O_VS = 25067520;
constexpr size_t WS_WIN = 0, WS_WOUT = 12582912, WS_WGU = 20971520, WS_WDN = 67108864, WS_PWT = 90177536, WS_WSB = 90701824,
                 WS_XB = 91226112, WS_R1 = 126877696, WS_HALO = 224919552, WS_FIX = 228005888, WS_STAT = 234178560, WS_VSP = 235292672, WS_BAR = 235849728, WS_END = 235937280;
constexpr size_t R1_ZP = 0, R1_ZU = 17825792, R1_ZV = 35651584, R1_MIX = 53477376;
constexpr int LDS_BYTES = 131072 + 16;

struct Params {
    const float* in[19];
    float* out;
    unsigned char* ws;
};
enum { I_XP = 0, I_XS, I_SPOOL, I_SCONV, I_N1G, I_WIN, I_POOLW, I_PSCALE, I_VNG, I_WSP, I_BSP, I_WOUT, I_N2G, I_WGATE, I_WUP, I_CONVW, I_CONVB, I_WDOWN, I_FNG };

__device__ __forceinline__ unsigned cvt_pk_bf16(float lo, float hi) { unsigned r; asm("v_cvt_pk_bf16_f32 %0, %1, %2" : "=v"(r) : "v"(lo), "v"(hi)); return r; }
__device__ __forceinline__ bf16_t f2bf(float f) { return (bf16_t)(cvt_pk_bf16(f, 0.f) & 0xffffu); }
__device__ __forceinline__ float bf2f(bf16_t b) { return __uint_as_float(((unsigned)b) << 16); }
__device__ __forceinline__ float bflo(unsigned w) { return __uint_as_float(w << 16); }
__device__ __forceinline__ float bfhi(unsigned w) { return __uint_as_float(w & 0xffff0000u); }
__device__ __forceinline__ float gelu_f(float v) {
    const float av = fabsf(v), d = av * 0.2316418882f + 1.0f;
    const float t = __builtin_amdgcn_rcpf(d);
    float q = t * 0.5307027145f + (-0.7265760135f); q = q * t + 0.7107068705f; q = q * t + (-0.142248368f); q = q * t + 0.127414796f; q = q * t;
    const float e = __builtin_amdgcn_exp2f(v * v * (-0.72134752044f));
    const float m = v * (q * e);
    return v < 0.f ? m : v - m;
}
typedef float f32x2 __attribute__((ext_vector_type(2)));
__device__ __forceinline__ f32x2 gelu_pk(f32x2 v) {
    const f32x2 av = __builtin_elementwise_abs(v), d = av * 0.2316418882f + 1.0f;
    f32x2 t; t.x = __builtin_amdgcn_rcpf(d.x); t.y = __builtin_amdgcn_rcpf(d.y);
    f32x2 q = t * 0.5307027145f + (-0.7265760135f); q = q * t + 0.7107068705f; q = q * t + (-0.142248368f); q = q * t + 0.127414796f; q = q * t;
    const f32x2 u = v * 0.8493218003f, s = -(u * u);
    f32x2 e; e.x = __builtin_amdgcn_exp2f(s.x); e.y = __builtin_amdgcn_exp2f(s.y);
    const f32x2 h = 0.5f - q * e;
    return v * 0.5f + av * h;
}
__device__ __forceinline__ f32x4 gelu4(f32x4 v) { const f32x2 a = gelu_pk((f32x2){v[0], v[1]}), b = gelu_pk((f32x2){v[2], v[3]}); return (f32x4){a.x, a.y, b.x, b.y}; }
__device__ __forceinline__ float sum16(const float* p) { const f32x4 a = *(const f32x4*)p, b = *(const f32x4*)(p + 4), c = *(const f32x4*)(p + 8), d = *(const f32x4*)(p + 12); const f32x4 s = (a + b) + (c + d); return (s[0] + s[1]) + (s[2] + s[3]); }
__device__ __forceinline__ float wave_sum(float v) {
#pragma unroll
    for (int o = 1; o < 64; o <<= 1) v += __shfl_xor(v, o);
    return v;
}

__device__ __forceinline__ int opaque_tid() { int t = threadIdx.x; asm volatile("" : "+v"(t)); return t; }

#define XB_TMO      128
#define XB_XCNT(j)  (256  + 64 * (j))
#define XB_XSUB(j)  (1280 + 64 * (j))
#define XB_XGEN(j)  (2304 + 64 * (j))
#define XB_TOP      3328
#define XB_TOPGEN   3392
#define XCD_BAR_WORDS 3456
#define XB_SPIN_CAP (1u << 22)
__device__ __forceinline__ unsigned xb_ld(unsigned* p)              { return __hip_atomic_load(p, __ATOMIC_RELAXED, __HIP_MEMORY_SCOPE_AGENT); }
__device__ __forceinline__ unsigned xb_add(unsigned* p, unsigned v) { return __hip_atomic_fetch_add(p, v, __ATOMIC_RELAXED, __HIP_MEMORY_SCOPE_AGENT); }
__device__ __forceinline__ unsigned xb_xcc_id() { return (unsigned)__builtin_amdgcn_s_getreg((3 << 11) | 20) & 0xFu; }
#define XB_SPIN(cond, bar) do { unsigned _sp = 0; while (cond) { __builtin_amdgcn_s_sleep(1); \
    if ((++_sp & 255u) == 0u) { if (xb_ld(&(bar)[XB_TMO])) break; if (_sp > XB_SPIN_CAP) { atomicAdd(&(bar)[XB_TMO], 1u); break; } } } } while (0)
struct XcdBarrier { unsigned* bar; unsigned x; volatile LAS unsigned* st; };
__device__ __forceinline__ XcdBarrier xcd_barrier_post(unsigned* bar, volatile LAS unsigned* st) {
    XcdBarrier b; b.bar = bar; b.x = xb_xcc_id(); b.st = st;
    if (threadIdx.x == 0) (void)xb_add(&bar[XB_XCNT(b.x)], 1u);
    return b;
}
__device__ __forceinline__ void xcd_barrier_complete(unsigned* bar, unsigned x, unsigned& nloc, unsigned& nx) {
    const unsigned G = gridDim.x * gridDim.y * gridDim.z;
    unsigned sum, cnt, mine, sp = 0u;
    for (;;) {
        sum = 0u; cnt = 0u; mine = 0u;
#pragma unroll
        for (unsigned j = 0; j < 16; ++j) { const unsigned c = xb_ld(&bar[XB_XCNT(j)]); sum += c; cnt += (c > 0u) ? 1u : 0u; mine = (j == x) ? c : mine; }
        if (sum == G) break;
        __builtin_amdgcn_s_sleep(1);
        if ((++sp & 255u) == 0u) { if (xb_ld(&bar[XB_TMO])) break; if (sp > XB_SPIN_CAP) { atomicAdd(&bar[XB_TMO], 1u); break; } }
    }
    nloc = mine > 0u ? mine : 1u; nx = cnt > 0u ? cnt : 1u;
}
__device__ __forceinline__ void xcd_barrier(const XcdBarrier& b) {
    asm volatile("s_waitcnt vmcnt(0)" ::: "memory");
    __syncthreads();
    if (threadIdx.x == 0) {
        unsigned* bar = b.bar;
        __builtin_amdgcn_s_waitcnt(0);
        unsigned nloc = b.st[0], nx = b.st[1];
        if (nloc == 0u) { xcd_barrier_complete(bar, b.x, nloc, nx); b.st[0] = nloc; b.st[1] = nx; }
        const unsigned old = xb_add(&bar[XB_XSUB(b.x)], 1u);
        const unsigned gen = old / nloc;
        if (old + 1u == (gen + 1u) * nloc) {
            __builtin_amdgcn_fence(__ATOMIC_RELEASE, "agent");
            asm volatile("s_waitcnt vmcnt(0)" ::: "memory");
            const unsigned og = xb_add(&bar[XB_TOP], 1u);
            const unsigned tg = og / nx;
            if (og + 1u == (tg + 1u) * nx) xb_add(&bar[XB_TOPGEN], 1u);
            else XB_SPIN(xb_ld(&bar[XB_TOPGEN]) == tg, bar);
            __builtin_amdgcn_fence(__ATOMIC_ACQUIRE, "agent");
            xb_add(&bar[XB_XGEN(b.x)], 1u);
            asm volatile("s_waitcnt vmcnt(0)" ::: "memory");
        } else {
            XB_SPIN(xb_ld(&bar[XB_XGEN(b.x)]) == gen, bar);
            __builtin_amdgcn_fence(__ATOMIC_ACQUIRE, "agent");
            asm volatile("s_waitcnt vmcnt(0)" ::: "memory");
        }
    }
    __syncthreads();
}

constexpr int N_CNT = 32 + 256;
__device__ __forceinline__ unsigned* cnt_word(unsigned char* ws, int layer, int kind, int panel) { return (unsigned*)(ws + WS_BAR) + XCD_BAR_WORDS + ((layer * 2 + kind) * 4 + panel) * 64; }
__device__ __forceinline__ unsigned* pcnt_word(unsigned char* ws, int layer, int pm) { return (unsigned*)(ws + WS_BAR) + XCD_BAR_WORDS + (32 + layer * 64 + pm) * 64; }
__device__ __forceinline__ void st_wt64(void* p, u32x2 w) { __hip_atomic_store((unsigned long long*)p, (unsigned long long)w.x | ((unsigned long long)w.y << 32), __ATOMIC_RELAXED, __HIP_MEMORY_SCOPE_AGENT); }
__device__ __forceinline__ void wait_count(unsigned* word, unsigned need, unsigned* tmo) {
    if (threadIdx.x == 0) {
        unsigned sp = 0;
        while (xb_ld(word) < need) { __builtin_amdgcn_s_sleep(2); if ((++sp & 255u) == 0u) { if (xb_ld(tmo)) break; if (sp > XB_SPIN_CAP) { atomicAdd(tmo, 1u); break; } } }
        __builtin_amdgcn_fence(__ATOMIC_ACQUIRE, "agent");
        asm volatile("s_waitcnt vmcnt(0)" ::: "memory");
    }
    __syncthreads();
}

namespace pg8 {
constexpr int BM = 256, BK = 64, HALF = 128, HTB = HALF * BK * 2, NXCD = 8, WGM = 8;
__device__ __forceinline__ int lds_byte(int r, int c) { const int st = (r >> 4) * 2 + (c >> 5), rr = r & 15, cc = c & 31, ob = rr * 64 + cc * 2; return st * 1024 + (ob ^ (((ob >> 9) & 1) << 5)); }
__device__ __forceinline__ void stage_rc(int b, int& R, int& C) { const int st = b / 1024, sb = b % 1024, swz = sb ^ (((sb >> 9) & 1) << 5); R = (st >> 1) * 16 + swz / 64; C = (st & 1) * 32 + (swz % 64) / 2; }
__device__ __forceinline__ int perm32(int rho) { const int n = rho >> 4, i = rho & 15; return 8 * (i >> 2) + 4 * n + (i & 3); }
struct Unit { int pm, pn; };
struct Gemm { const bf16_t* A; const bf16_t* Bt; int M, N, K; };
struct StaticOrder {
    int nM, nN, nwg, G, c;
    __device__ __forceinline__ void init(int M, int N, int G_, int c_) { nM = M / BM; nN = N / BM; nwg = nM * nN; G = G_; c = c_; }
    __device__ __forceinline__ void map(int L, Unit& u) const {
        int wgid = L; { const int q = nwg / NXCD, r = nwg % NXCD, xcd = wgid % NXCD, off = wgid / NXCD; wgid = (xcd < r ? xcd * (q + 1) : r * (q + 1) + (xcd - r) * q) + off; }
        const int nig = WGM * nN, gid = wgid / nig, fm = gid * WGM, gsz = (nM - fm) < WGM ? (nM - fm) : WGM;
        u.pm = fm + ((wgid % nig) % gsz); u.pn = (wgid % nig) / gsz;
    }
    __device__ __forceinline__ bool next(int i, Unit& u) const { const long L = (long)i * G + c; if (L >= nwg) return false; map((int)L, u); return true; }
};
struct OneUnit { int pm, pn; __device__ __forceinline__ bool next(int i, Unit& u) const { if (i) return false; u.pm = pm; u.pn = pn; return true; } };
struct COrder {
    StaticOrder so; int c, seg;
    __device__ __forceinline__ bool next(int i, Unit& u) const {
        if (c < 128) { if (i > 5) return false; so.map(i * 256 + c, u); return true; }
        if (c < 216) { if (i > 5) return false; if (i == 0) { const int su = c - 128; u.pm = 64 + su / 22; u.pn = su % 22; return true; } so.map((i - 1) * 256 + c, u); return true; }
        if (c < 232) { if (i > 5) return false; so.map(i < 5 ? i * 256 + c : 1024 + 240 + (c - 216), u); return true; }
        if (c < 240) { if (i > 4) return false; so.map(i * 256 + c, u); return true; }
        if (seg == 0) { if (i > 0) return false; so.map(c, u); return true; }
        if (i > 2) return false; so.map((i + 1) * 256 + c, u); return true;
    }
};

template <class Epi, class Sched>
__device__ __forceinline__ void gemm_phase(LAS unsigned char* lds, const Gemm g, const Sched& S, const Epi& E) {
    const int tid = opaque_tid(), wid = __builtin_amdgcn_readfirstlane(tid >> 6), lane = tid & 63, wr = wid >> 2, wc = wid & 3, fr = lane & 15, fq = lane >> 4;
    const int K = g.K, nt = K / BK;
    unsigned voffA[2], voffB[2];
#pragma unroll
    for (int i = 0; i < 2; ++i) { int R, C; stage_rc(tid * 16 + i * 8192, R, C); const int Rb = (R & ~31) + perm32(R & 31);
        const int Ra = Epi::AROWPERM ? (8 * (16 * (R >> 6) + (R & 15)) + ((R >> 4) & 3)) : R;
        voffA[i] = (unsigned)(Ra * K + C) * 2u; voffB[i] = (unsigned)(Rb * K + C) * 2u; }
    const size_t kstep = (size_t)(BK * 2);
    const size_t hstepB = (size_t)HALF * K * 2;
    const size_t hstepA = Epi::AROWPERM ? (size_t)4 * K * 2 : hstepB;
    const size_t tstep = 2 * hstepB;
    const unsigned ldsw = (unsigned)wid * 1024u;
    const int aoff = lds_byte(wr * 64 + fr, fq * 8), boff = lds_byte(wc * 32 + fr, fq * 8);
#define PG8_SA(b, h) (((b) * 2 + (h)) * HTB)
#define PG8_SB(b, h) ((4 + (b) * 2 + (h)) * HTB)
#define PG8_STAGE(bufoff, gbase, voff) do { _Pragma("unroll") for (int _i = 0; _i < 2; ++_i) \
        __builtin_amdgcn_global_load_lds((const unsigned*)((const char*)(gbase) + (voff)[_i]), (LAS unsigned*)(lds + (bufoff) + ldsw + _i * 8192), 16, 0, 0); } while (0)
#define PG8_LDA(dst, b, h) do { _Pragma("unroll") for (int m = 0; m < 4; ++m) _Pragma("unroll") for (int k = 0; k < 2; ++k) dst[m][k] = *(const LAS bf16x8*)(lds + PG8_SA(b, h) + aoff + m * 2048 + k * 1024); } while (0)
#define PG8_LDB(dst, b, h) do { _Pragma("unroll") for (int n = 0; n < 2; ++n) _Pragma("unroll") for (int k = 0; k < 2; ++k) dst[n][k] = *(const LAS bf16x8*)(lds + PG8_SB(b, h) + boff + n * 2048 + k * 1024); } while (0)
#define PG8_MMA(ai, bj, At, Bt) do { __builtin_amdgcn_s_setprio(1); _Pragma("unroll") for (int m = 0; m < 4; ++m) _Pragma("unroll") for (int n = 0; n < 2; ++n) _Pragma("unroll") for (int k = 0; k < 2; ++k) \
        acc[ai][bj][m][n] = __builtin_amdgcn_mfma_f32_16x16x32_bf16(Bt[n][k], At[m][k], acc[ai][bj][m][n], 0, 0, 0); __builtin_amdgcn_s_setprio(0); } while (0)
#define PG8_WAIT_V(n) asm volatile("s_waitcnt vmcnt(" #n ")" ::: "memory")
#define PG8_WAIT_L(n) asm volatile("s_waitcnt lgkmcnt(" #n ")" ::: "memory")
#define PG8_BAR __builtin_amdgcn_s_barrier()
#define PG8_SCHED __builtin_amdgcn_sched_barrier(0)
    Unit cur, nxt; int ui = 0;
    if (!S.next(0, cur)) return;
    f32x4 acc[2][2][4][2];
    typename Epi::Raw raw;
    if constexpr (Epi::HAS_INIT) E.load_init(raw, cur, wr, wc);
    bf16x8 At[4][2], B0[2][2], B1[2][2];
    const char* cA = (const char*)g.A + (size_t)cur.pm * tstep; const char* cB = (const char*)g.Bt + (size_t)cur.pn * tstep;
    PG8_STAGE(PG8_SB(0, 0), cB, voffB); PG8_STAGE(PG8_SA(0, 0), cA, voffA); PG8_STAGE(PG8_SB(0, 1), cB + hstepB, voffB); PG8_STAGE(PG8_SA(0, 1), cA + hstepA, voffA);
    if (wr == 1) PG8_BAR;
    PG8_WAIT_V(4); PG8_BAR;
    PG8_STAGE(PG8_SB(1, 0), cB + kstep, voffB); PG8_STAGE(PG8_SA(1, 0), cA + kstep, voffA); PG8_STAGE(PG8_SB(1, 1), cB + hstepB + kstep, voffB);
    PG8_WAIT_V(6); PG8_BAR;
    if constexpr (Epi::HAS_INIT) E.apply_init(acc, raw);
    else {
#pragma unroll
        for (int a = 0; a < 2; ++a)
#pragma unroll
            for (int b = 0; b < 2; ++b)
#pragma unroll
                for (int m = 0; m < 4; ++m)
#pragma unroll
                    for (int n = 0; n < 2; ++n) acc[a][b][m][n] = (f32x4){0.f, 0.f, 0.f, 0.f};
    }
    for (;;) {
        const bool has_next = S.next(ui + 1, nxt);
        const char* nA = has_next ? (const char*)g.A + (size_t)nxt.pm * tstep : cA; const char* nB = has_next ? (const char*)g.Bt + (size_t)nxt.pn * tstep : cB;
        for (int t = 0; t < nt; t += 2) {
            const bool last = (t == nt - 2);
            const char* a1 = cA + (size_t)(t + 1) * kstep;
            const char* a2 = last ? nA : cA + (size_t)(t + 2) * kstep; const char* b2 = last ? nB : cB + (size_t)(t + 2) * kstep;
            const char* a3 = a2 + kstep; const char* b3 = b2 + kstep;
            PG8_LDB(B0, 0, 0); PG8_SCHED; PG8_LDA(At, 0, 0); PG8_STAGE(PG8_SA(1, 1), a1 + hstepA, voffA);
            PG8_WAIT_L(8); PG8_BAR; PG8_WAIT_L(0); PG8_MMA(0, 0, At, B0); PG8_BAR; PG8_SCHED;
            PG8_LDB(B1, 0, 1); PG8_STAGE(PG8_SB(0, 0), b2, voffB);
            PG8_BAR; PG8_WAIT_L(0); PG8_MMA(0, 1, At, B1); PG8_BAR;
            PG8_LDA(At, 0, 1); PG8_STAGE(PG8_SA(0, 0), a2, voffA);
            PG8_BAR; PG8_WAIT_L(0); PG8_MMA(1, 0, At, B0); PG8_BAR; PG8_SCHED;
            PG8_STAGE(PG8_SB(0, 1), b2 + hstepB, voffB);
            PG8_WAIT_V(6); PG8_BAR; PG8_MMA(1, 1, At, B1); PG8_BAR;
            PG8_LDB(B0, 1, 0); PG8_SCHED; PG8_LDA(At, 1, 0); PG8_STAGE(PG8_SA(0, 1), a2 + hstepA, voffA);
            PG8_WAIT_L(8); PG8_BAR; PG8_WAIT_L(0); PG8_MMA(0, 0, At, B0); PG8_BAR; PG8_SCHED;
            PG8_LDB(B1, 1, 1); PG8_STAGE(PG8_SB(1, 0), b3, voffB);
            PG8_BAR; PG8_WAIT_L(0); PG8_MMA(0, 1, At, B1); PG8_BAR;
            PG8_LDA(At, 1, 1); PG8_STAGE(PG8_SA(1, 0), a3, voffA);
            PG8_BAR; PG8_WAIT_L(0); PG8_MMA(1, 0, At, B0); PG8_BAR; PG8_SCHED;
            PG8_STAGE(PG8_SB(1, 1), b3 + hstepB, voffB);
            PG8_WAIT_V(6); PG8_BAR; PG8_MMA(1, 1, At, B1); PG8_BAR;
        }
        E(acc, cur, wr, wc, fr, fq);
        if (!has_next) break;
        if constexpr (Epi::HAS_INIT) { E.load_init(raw, nxt, wr, wc); E.apply_init(acc, raw); }
        else {
#pragma unroll
            for (int a = 0; a < 2; ++a)
#pragma unroll
                for (int b = 0; b < 2; ++b)
#pragma unroll
                    for (int m = 0; m < 4; ++m)
#pragma unroll
                        for (int n = 0; n < 2; ++n) acc[a][b][m][n] = (f32x4){0.f, 0.f, 0.f, 0.f};
        }
        cur = nxt; cA = nA; cB = nB; ++ui;
    }
    PG8_WAIT_V(0);
    if (wr == 0) PG8_BAR;
    PG8_BAR;
#undef PG8_SA
#undef PG8_SB
#undef PG8_STAGE
#undef PG8_LDA
#undef PG8_LDB
#undef PG8_MMA
#undef PG8_WAIT_V
#undef PG8_WAIT_L
#undef PG8_BAR
#undef PG8_SCHED
}
}

struct NoRaw {};
struct EpiA {
    static constexpr bool AROWPERM = false, HAS_INIT = false; typedef NoRaw Raw;
    const float* ss1; bf16_t* zp; float* vss; float* poolP; float* poolS;
    __device__ __forceinline__ void operator()(const f32x4 (&acc)[2][2][4][2], const pg8::Unit& u, int wr, int wc, int fr_, int fq_) const {
        const int lane_ = opaque_tid() & 63, fr = lane_ & 15, fq = lane_ >> 4;
        const int row0 = u.pm * 256 + wr * 64 + fr;
        const int kind = u.pn >> 1;
        const int colt = (u.pn & 1) * 256 + wc * 32 + 8 * fq;
        bf16_t* base = zp + (size_t)kind * ((size_t)MT * 512);
        float my0, my1;
        { const int k0 = 2 * fq, k1 = k0 + 1;
          my0 = rsqrtf(sum16(ss1 + (size_t)(row0 + 128 * (k0 >> 2) + 16 * (k0 & 3)) * 16) * (1.0f / 1024.0f) + EPS);
          my1 = rsqrtf(sum16(ss1 + (size_t)(row0 + 128 * (k1 >> 2) + 16 * (k1 & 3)) * 16) * (1.0f / 1024.0f) + EPS); }
        float rsv[8];
#pragma unroll
        for (int k = 0; k < 8; ++k) rsv[k] = __shfl((k & 1) ? my1 : my0, (k >> 1) * 16 + fr);
#pragma unroll
        for (int ai = 0; ai < 2; ++ai)
#pragma unroll
            for (int m = 0; m < 4; ++m) {
                const int row = row0 + ai * 128 + m * 16;
                const float rs = rsv[ai * 4 + m];
                float ssum = 0.f;
#pragma unroll
                for (int bj = 0; bj < 2; ++bj) {
                    f32x4 v0 = acc[ai][bj][m][0] * rs, v1 = acc[ai][bj][m][1] * rs;
                    const int col = colt + bj * 128;
                    if (kind == 0) {
                        if (row < MP) { const int t = row & 2047; if (t >= 2033) { float* o = poolP + ((size_t)(row >> 11) * 15 + (t - 2033)) * 512 + col; *(f32x4*)o = v0; *(f32x4*)(o + 4) = v1; } }
                        else { const int rr = row - MP; float* o = poolS + ((size_t)(rr >> 3) * 15 + 7 + (rr & 7)) * 512 + col; *(f32x4*)o = v0; *(f32x4*)(o + 4) = v1; }
                    } else {
                        v0 = gelu4(v0); v1 = gelu4(v1);
                        if (kind == 2) ssum += (v0[0] * v0[0] + v0[1] * v0[1]) + (v0[2] * v0[2] + v0[3] * v0[3]) + (v1[0] * v1[0] + v1[1] * v1[1]) + (v1[2] * v1[2] + v1[3] * v1[3]);
                    }
                    u32x4 w; w.x = cvt_pk_bf16(v0[0], v0[1]); w.y = cvt_pk_bf16(v0[2], v0[3]); w.z = cvt_pk_bf16(v1[0], v1[1]); w.w = cvt_pk_bf16(v1[2], v1[3]);
                    *(u32x4*)(base + (size_t)row * 512 + col) = w;
                }
                if (kind == 2) { ssum += __shfl_xor(ssum, 16); ssum += __shfl_xor(ssum, 32); if (fq == 0) vss[(size_t)row * 8 + (u.pn & 1) * 4 + wc] = ssum; }
            }
    }
};
template <bool FROM_IN> struct EpiX {
    static constexpr bool AROWPERM = false, HAS_INIT = !FROM_IN;
    struct Raw { u32x4 r[2][4][2]; };
    const float* xin_p; const float* xin_s; bf16_t* xb; float* ssout;
    __device__ __forceinline__ void load_init(Raw& raw, const pg8::Unit& u, int wr, int wc) const {
        const int lane_ = opaque_tid() & 63, fr = lane_ & 15, fq = lane_ >> 4;
        const bf16_t* p = xb + (size_t)(u.pm * 256 + wr * 64 + fr) * D + u.pn * 256 + wc * 32 + 8 * fq;
#pragma unroll
        for (int ai = 0; ai < 2; ++ai)
#pragma unroll
            for (int m = 0; m < 4; ++m)
#pragma unroll
                for (int bj = 0; bj < 2; ++bj) raw.r[ai][m][bj] = *(const u32x4*)(p + (size_t)(ai * 128 + m * 16) * D + bj * 128);
    }
    __device__ __forceinline__ void apply_init(f32x4 (&acc)[2][2][4][2], const Raw& raw) const {
#pragma unroll
        for (int ai = 0; ai < 2; ++ai)
#pragma unroll
            for (int m = 0; m < 4; ++m)
#pragma unroll
                for (int bj = 0; bj < 2; ++bj) {
                    const u32x4 r = raw.r[ai][m][bj]; acc[ai][bj][m][0] = (f32x4){bflo(r.x), bfhi(r.x), bflo(r.y), bfhi(r.y)}; acc[ai][bj][m][1] = (f32x4){bflo(r.z), bfhi(r.z), bflo(r.w), bfhi(r.w)};
                }
    }
    __device__ __forceinline__ void operator()(const f32x4 (&acc)[2][2][4][2], const pg8::Unit& u, int wr, int wc, int fr_, int fq_) const {
        const int lane_ = opaque_tid() & 63, fr = lane_ & 15, fq = lane_ >> 4;
        const int row0 = u.pm * 256 + wr * 64 + fr, col0 = u.pn * 256 + wc * 32 + 8 * fq;
#pragma unroll
        for (int ai = 0; ai < 2; ++ai)
#pragma unroll
            for (int m = 0; m < 4; ++m) {
                const int row = row0 + ai * 128 + m * 16;
                float ssum = 0.f;
#pragma unroll
                for (int bj = 0; bj < 2; ++bj) {
                    const int col = col0 + bj * 128;
                    f32x4 v0 = acc[ai][bj][m][0], v1 = acc[ai][bj][m][1];
                    if constexpr (FROM_IN) { const float* xo = row < MP ? xin_p + (size_t)row * D : xin_s + (size_t)(row - MP) * D; v0 += *(const f32x4*)(xo + col); v1 += *(const f32x4*)(xo + col + 4); }
                    ssum += (v0[0] * v0[0] + v0[1] * v0[1]) + (v0[2] * v0[2] + v0[3] * v0[3]) + (v1[0] * v1[0] + v1[1] * v1[1]) + (v1[2] * v1[2] + v1[3] * v1[3]);
                    u32x4 w; w.x = cvt_pk_bf16(v0[0], v0[1]); w.y = cvt_pk_bf16(v0[2], v0[3]); w.z = cvt_pk_bf16(v1[0], v1[1]); w.w = cvt_pk_bf16(v1[2], v1[3]);
                    *(u32x4*)(xb + (size_t)row * D + col) = w;
                }
                ssum += __shfl_xor(ssum, 16); ssum += __shfl_xor(ssum, 32); if (fq == 0) ssout[(size_t)row * 16 + u.pn * 4 + wc] = ssum;
            }
    }
};
struct EpiC {
    static constexpr bool AROWPERM = true, HAS_INIT = false; typedef NoRaw Raw;
    const float* ss2; const float* cw; const float* cb; const float* sconv; bf16_t* act; float* halo; float* fix; float* convP; float* convS; unsigned* actcnt;
    __device__ __forceinline__ void operator()(const f32x4 (&acc)[2][2][4][2], const pg8::Unit& u, int wr, int wc, int fr_, int fq_) const {
        const int lane_ = opaque_tid() & 63, fr = lane_ & 15, fq = lane_ >> 4;
        const int q = 16 * wr + fr;
        const int tok0 = u.pm * 256 + 8 * q;
        const bool sample = (u.pm * 256) >= MP;
        const float my0 = rsqrtf(sum16(ss2 + (size_t)(tok0 + 2 * fq) * 16) * (1.0f / 1024.0f) + EPS), my1 = rsqrtf(sum16(ss2 + (size_t)(tok0 + 2 * fq + 1) * 16) * (1.0f / 1024.0f) + EPS);
        float rs[8];
#pragma unroll
        for (int k = 0; k < 8; ++k) rs[k] = __shfl((k & 1) ? my1 : my0, (k >> 1) * 16 + fr);
        const int cgl = u.pn * 128 + wc * 32 + 8 * fq;
        const bool first = (fr == 0), lastl = (fr == 15);
        const int bidx = 2 * u.pm + wr;
        const bool seqstart = (bidx & 15) == 0;
        const bool deferred = !sample && first && !seqstart;
        const int sb = sample ? ((tok0 - MP) >> 3) : 0;
#pragma unroll
        for (int n = 0; n < 2; ++n) {
            const int c = cgl + 4 * n;
            const f32x4 w0 = *(const f32x4*)(cw + c), w1 = *(const f32x4*)(cw + FF + c), w2 = *(const f32x4*)(cw + 2 * FF + c), bb = *(const f32x4*)(cb + c);
            const f32x4 g6 = acc[1][0][2][n] * rs[6], g7 = acc[1][0][3][n] * rs[7];
            f32x4 gm1, gm2;
            if (sample) { gm2 = *(const f32x4*)(sconv + ((size_t)sb * 2 + 0) * FF + c); gm1 = *(const f32x4*)(sconv + ((size_t)sb * 2 + 1) * FF + c); }
            else {
#pragma unroll
                for (int j = 0; j < 4; ++j) { gm1[j] = __shfl_up(g7[j], 1, 16); gm2[j] = __shfl_up(g6[j], 1, 16); }
                if (first) { gm1 = (f32x4){0.f, 0.f, 0.f, 0.f}; gm2 = gm1; }
            }
#pragma unroll
            for (int k = 0; k < 8; ++k) {
                const f32x4 gk = acc[k >> 2][0][k & 3][n] * rs[k], uk = acc[k >> 2][1][k & 3][n] * rs[k];
                const f32x4 cv = bb + w0 * gm2 + w1 * gm1 + w2 * gk;
                const f32x4 a = gelu4(cv) * uk;
                if (!(deferred && k < 2)) { u32x2 w; w.x = cvt_pk_bf16(a[0], a[1]); w.y = cvt_pk_bf16(a[2], a[3]); if (sample) st_wt64(act + (size_t)(tok0 + k) * FF + c, w); else *(u32x2*)(act + (size_t)(tok0 + k) * FF + c) = w; }
                if (k < 2 && deferred) { float* o = fix + (((size_t)bidx * 2 + k) * FF + c) * 2;
                    *(f32x4*)o = (f32x4){gk[0], uk[0], gk[1], uk[1]}; *(f32x4*)(o + 4) = (f32x4){gk[2], uk[2], gk[3], uk[3]}; }
                gm2 = gm1; gm1 = gk;
            }
            if (!sample) {
                if (lastl) {
                    const int hb = bidx + 1;
                    *(f32x4*)(halo + ((size_t)hb * 2 + 0) * FF + c) = g6; *(f32x4*)(halo + ((size_t)hb * 2 + 1) * FF + c) = g7;
                    if ((hb & 15) == 0) { const int b = (hb >> 4) - 1; *(f32x4*)(convP + ((size_t)b * 2 + 0) * FF + c) = g6; *(f32x4*)(convP + ((size_t)b * 2 + 1) * FF + c) = g7; }
                }
            } else { *(f32x4*)(convS + ((size_t)sb * 2 + 0) * FF + c) = g6; *(f32x4*)(convS + ((size_t)sb * 2 + 1) * FF + c) = g7; }
        }
        if (sample) { asm volatile("s_waitcnt vmcnt(0)" ::: "memory"); if (lane_ == 0) xb_add(actcnt + (u.pm - 64) * 64, 1u); }
    }
};

struct TDesc { const float* W; const float* gk; const float* gn; bf16_t* WT; int N, ldk, dst_row0, k0, n0; };
struct TRegs { f32x4 v[8]; };
__device__ __forceinline__ void t_load(const TDesc& d, TRegs& t, int lane) {
    const int c4 = lane & 7;
    f32x4 gnv = (f32x4){1.f, 1.f, 1.f, 1.f};
    if (d.gn) gnv = *(const f32x4*)(d.gn + d.n0 + 4 * c4);
#pragma unroll
    for (int i = 0; i < 8; ++i) { const int kk = 8 * i + (lane >> 3); f32x4 v = __builtin_nontemporal_load((const f32x4*)(d.W + (size_t)(d.k0 + kk) * d.N + d.n0 + 4 * c4)) * gnv; if (d.gk) v *= d.gk[d.k0 + kk]; t.v[i] = v; }
}
__device__ __forceinline__ void t_store(const TDesc& d, const TRegs& t, LAS float* scr, int lane) {
    const int c4 = lane & 7;
#pragma unroll
    for (int i = 0; i < 8; ++i) { const int kk = 8 * i + (lane >> 3); LAS float* q = scr + kk * 33 + 4 * c4; q[0] = t.v[i][0]; q[1] = t.v[i][1]; q[2] = t.v[i][2]; q[3] = t.v[i][3]; }
    asm volatile("s_waitcnt lgkmcnt(0)" ::: "memory");
    const int c = lane & 7;
#pragma unroll
    for (int j = 0; j < 4; ++j) { const int n = (lane >> 3) + 8 * j; const LAS float* sp = scr + (8 * c) * 33 + n;
        u32x4 o; o.x = cvt_pk_bf16(sp[0 * 33], sp[1 * 33]); o.y = cvt_pk_bf16(sp[2 * 33], sp[3 * 33]); o.z = cvt_pk_bf16(sp[4 * 33], sp[5 * 33]); o.w = cvt_pk_bf16(sp[6 * 33], sp[7 * 33]);
        *(u32x4*)(d.WT + (size_t)(d.dst_row0 + n) * d.ldk + d.k0 + 8 * c) = o; }
    asm volatile("s_waitcnt lgkmcnt(0)" ::: "memory");
}
__device__ __forceinline__ void t_decode(const Params& P, int it, TDesc& d) {
    const int l = it / 5536; int r = it % 5536;
    d.gk = nullptr; d.gn = nullptr;
    if (r < 768) { const int kb = r / 48, nb = r % 48; d.W = P.in[I_WIN] + (size_t)l * D * INW; d.N = INW; d.gk = P.in[I_N1G] + l * D; d.WT = (bf16_t*)(P.ws + WS_WIN) + (size_t)l * INW * D; d.ldk = D; d.dst_row0 = 32 * nb; d.k0 = 64 * kb; d.n0 = 32 * nb; return; } r -= 768;
    if (r < 512) { const int kb = r / 32, nb = r % 32; d.W = P.in[I_WOUT] + (size_t)l * D * D; d.N = D; d.WT = (bf16_t*)(P.ws + WS_WOUT) + (size_t)l * D * D; d.ldk = D; d.dst_row0 = 32 * nb; d.k0 = 64 * kb; d.n0 = 32 * nb; return; } r -= 512;
    if (r < 2816) { const int up = r >= 1408; if (up) r -= 1408; const int kb = r / 88, nb = r % 88, n0 = 32 * nb; d.W = (up ? P.in[I_WUP] : P.in[I_WGATE]) + (size_t)l * D * FF; d.N = FF; d.gk = P.in[I_N2G] + l * D;
        d.WT = (bf16_t*)(P.ws + WS_WGU) + (size_t)l * NGU * D; d.ldk = D; d.dst_row0 = 256 * (n0 >> 7) + 128 * up + (n0 & 127); d.k0 = 64 * kb; d.n0 = n0; return; } r -= 2816;
    if (r < 1408) { const int kb = r / 32, nb = r % 32; d.W = P.in[I_WDOWN] + (size_t)l * FF * D; d.N = D; d.WT = (bf16_t*)(P.ws + WS_WDN) + (size_t)l * D * FF; d.ldk = FF; d.dst_row0 = 32 * nb; d.k0 = 64 * kb; d.n0 = 32 * nb; return; } r -= 1408;
    { const int gi = r >> 3, rr = r & 7, kb = rr >> 2, nb = rr & 3; d.W = P.in[I_POOLW] + (size_t)(l * 4 + gi) * 16384; d.N = 128; d.gn = P.in[I_PSCALE] + l * 512 + gi * 128;
      d.WT = (bf16_t*)(P.ws + WS_PWT) + (size_t)(l * 4 + gi) * 16384; d.ldk = 128; d.dst_row0 = 32 * nb; d.k0 = 64 * kb; d.n0 = 32 * nb; }
}

__device__ __forceinline__ void convert_weights(const Params& P, LAS unsigned char* lds, int layer, int lo, int hi, int gw, int NGW) {
    const int tid = opaque_tid(), lane = tid & 63, wid = tid >> 6;
    LAS float* scr = (LAS float*)(lds + wid * 8704);
    const int base = layer * 5536;
    int it = lo + gw;
    TDesc dc, dn; TRegs tc, tn;
    if (it < hi) { t_decode(P, base + it, dc); t_load(dc, tc, lane); }
    while (it < hi) {
        const int itn = it + NGW; const bool hn = itn < hi;
        if (hn) { t_decode(P, base + itn, dn); t_load(dn, tn, lane); }
        t_store(dc, tc, scr, lane);
        if (hn) { dc = dn; tc = tn; }
        it = itn;
    }
}

__device__ __forceinline__ void phase0(const Params& P, LAS unsigned char* lds) {
    const int tid = opaque_tid(), lane = tid & 63, wid = tid >> 6;
    const int gw = blockIdx.x * 8 + wid, NGW = gridDim.x * 8;
    const int gtid = blockIdx.x * 512 + tid, NT = gridDim.x * 512;
    float* stat = (float*)(P.ws + WS_STAT);
    bf16_t* xb = (bf16_t*)(P.ws + WS_XB);
    for (int row = gw; row < MT; row += NGW) {
        const float* xr = row < MP ? P.in[I_XP] + (size_t)row * D : P.in[I_XS] + (size_t)(row - MP) * D;
        f32x4 v[4]; float s = 0.f;
#pragma unroll
        for (int j = 0; j < 4; ++j) { v[j] = __builtin_nontemporal_load((const f32x4*)xr + lane + 64 * j); s += (v[j][0] * v[j][0] + v[j][1] * v[j][1]) + (v[j][2] * v[j][2] + v[j][3] * v[j][3]); }
        s = wave_sum(s);
#pragma unroll
        for (int j = 0; j < 4; ++j) { u32x2 w; w.x = cvt_pk_bf16(v[j][0], v[j][1]); w.y = cvt_pk_bf16(v[j][2], v[j][3]); ((u32x2*)(xb + (size_t)row * D))[lane + 64 * j] = w; }
        if (lane < 16) stat[(size_t)row * 16 + lane] = lane == 0 ? s : 0.f;
    }
    convert_weights(P, lds, 0, 0, 768, gw, NGW);
    { const f32x4* sp = (const f32x4*)P.in[I_SPOOL]; f32x4* o = (f32x4*)(P.out + O_POOLS);
      for (int i = gtid; i < 4 * 128 * 7 * 128; i += NT) { const int c4 = i & 127, rr = (i >> 7) % 7, lb = (i >> 7) / 7; o[((size_t)lb * 15 + rr) * 128 + c4] = sp[((size_t)lb * 15 + rr + 8) * 128 + c4]; } }
    { bf16_t* WSB = (bf16_t*)(P.ws + WS_WSB); const float* wsp = P.in[I_WSP];
      for (int i = gtid; i < 4 * 4 * 128 * 128; i += NT) { const int s = i & 127, t = (i >> 7) & 127; WSB[i] = (s <= t) ? f2bf(wsp[i]) : (bf16_t)0; } }
}

constexpr int MLD = 136;
template <int W> __device__ __forceinline__ void pool_sample_stage(const Params& P, int layer, int gi, int tt, LAS bf16_t* sA, int tid) {
    const bf16_t* ZP = (const bf16_t*)(P.ws + WS_R1 + R1_ZP);
    const int r0 = tt * 128;
    for (int pi = tid; pi < 2048; pi += 512) {
        const int c = pi & 127, bl = pi >> 7; const int b = (tt - 128) * 16 + bl;
        const float* sp = P.in[I_SPOOL] + (((size_t)layer * 128 + b) * 15) * 512 + 128 * gi + c;
        float full[23];
#pragma unroll
        for (int i = 0; i < 15; ++i) full[i] = (i >= 16 - W) ? sp[(size_t)i * 512] : 0.f;
        const bf16_t* zp = ZP + (size_t)(r0 + bl * 8) * 512 + 128 * gi + c;
#pragma unroll
        for (int t = 0; t < 8; ++t) full[15 + t] = bf2f(zp[(size_t)t * 512]);
#pragma unroll
        for (int t = 0; t < 8; ++t) { float s = 0.f;
#pragma unroll
            for (int i = 0; i < W; ++i) s += full[15 + t - i];
            sA[(bl * 8 + t) * MLD + c] = f2bf(s * (1.0f / W) - full[15 + t]); }
    }
}

__device__ __forceinline__ void mixer_phase(const Params& P, int layer, LAS unsigned char* lds, int c2, int G2) {
    const int tid = opaque_tid(), lane = tid & 63, wid = tid >> 6;
    LAS bf16_t* sA = (LAS bf16_t*)lds;
    LAS bf16_t* sB = (LAS bf16_t*)(lds + 34816);
    LAS bf16_t* sP = (LAS bf16_t*)(lds + 69632);
    const bf16_t* ZP = (const bf16_t*)(P.ws + WS_R1 + R1_ZP); const bf16_t* ZU = (const bf16_t*)(P.ws + WS_R1 + R1_ZU); const bf16_t* ZV = (const bf16_t*)(P.ws + WS_R1 + R1_ZV);
    bf16_t* MIX = (bf16_t*)(P.ws + WS_R1 + R1_MIX);
    const float* vss = (const float*)(P.ws + WS_VSP);
    for (int it2 = c2; it2 < 1088; it2 += G2) {
        const int it = it2 < 64 ? 1024 + it2 : it2 - 64;
        const int tt = it >> 3, j = it & 7, r0 = tt * 128;
        const bool sample = tt >= 128;
        if (j < 4) {
            const int gi = j;
            const bf16_t* pw = (const bf16_t*)(P.ws + WS_PWT) + (size_t)(layer * 4 + gi) * 16384;
            for (int e = tid; e < 2048; e += 512) { const int n = e >> 4, ch = e & 15; *(LAS u32x4*)(sB + n * MLD + ch * 8) = *(const u32x4*)(pw + n * 128 + ch * 8); }
            if (!sample) {
                const bf16_t* zp = ZP + 128 * gi;
                for (int e = tid; e < 143 * 16; e += 512) { const int row = e >> 4, ch = e & 15; const int grow = r0 - 15 + row; u32x4 v = (u32x4){0u, 0u, 0u, 0u};
                    if (row >= 15 || (tt & 15) != 0) v = *(const u32x4*)(zp + (size_t)grow * 512 + ch * 8);
                    *(LAS u32x4*)(sP + row * 128 + ch * 8) = v; }
                __syncthreads();
                const int ch = tid & 15, seg = tid >> 4; const int w = 2 << gi;
                const int tpos0 = (r0 & 2047) + seg * 4;
                float sm[8];
#pragma unroll
                for (int q = 0; q < 8; ++q) sm[q] = 0.f;
                for (int i = 1; i < w; ++i) { const u32x4 pr = *(const LAS u32x4*)(sP + (15 + seg * 4 - i) * 128 + ch * 8);
                    sm[0] += bflo(pr.x); sm[1] += bfhi(pr.x); sm[2] += bflo(pr.y); sm[3] += bfhi(pr.y); sm[4] += bflo(pr.z); sm[5] += bfhi(pr.z); sm[6] += bflo(pr.w); sm[7] += bfhi(pr.w); }
#pragma unroll
                for (int rr = 0; rr < 4; ++rr) {
                    const int row = seg * 4 + rr;
                    const u32x4 pr = *(const LAS u32x4*)(sP + (15 + row) * 128 + ch * 8);
                    float pv[8] = {bflo(pr.x), bfhi(pr.x), bflo(pr.y), bfhi(pr.y), bflo(pr.z), bfhi(pr.z), bflo(pr.w), bfhi(pr.w)};
                    const float inv = 1.0f / (float)min(tpos0 + rr + 1, w);
                    float dv[8];
#pragma unroll
                    for (int q = 0; q < 8; ++q) { sm[q] += pv[q]; dv[q] = sm[q] * inv - pv[q]; }
                    u32x4 o; o.x = cvt_pk_bf16(dv[0], dv[1]); o.y = cvt_pk_bf16(dv[2], dv[3]); o.z = cvt_pk_bf16(dv[4], dv[5]); o.w = cvt_pk_bf16(dv[6], dv[7]);
                    *(LAS u32x4*)(sA + row * MLD + ch * 8) = o;
                    const u32x4 ps = *(const LAS u32x4*)(sP + (15 + row - w + 1) * 128 + ch * 8);
                    sm[0] -= bflo(ps.x); sm[1] -= bfhi(ps.x); sm[2] -= bflo(ps.y); sm[3] -= bfhi(ps.y); sm[4] -= bflo(ps.z); sm[5] -= bfhi(ps.z); sm[6] -= bflo(ps.w); sm[7] -= bfhi(ps.w);
                }
            } else {
                if (gi == 0) pool_sample_stage<2>(P, layer, gi, tt, sA, tid);
                else if (gi == 1) pool_sample_stage<4>(P, layer, gi, tt, sA, tid);
                else if (gi == 2) pool_sample_stage<8>(P, layer, gi, tt, sA, tid);
                else pool_sample_stage<16>(P, layer, gi, tt, sA, tid);
            }
        } else {
            const int h = j - 4;
            const bf16_t* wsb = (const bf16_t*)(P.ws + WS_WSB) + (size_t)(layer * 4 + h) * 16384;
            if (!sample) { for (int e = tid; e < 2048; e += 512) { const int row = e >> 4, ch = e & 15; *(LAS u32x4*)(sA + row * MLD + ch * 8) = *(const u32x4*)(wsb + row * 128 + ch * 8); } }
            else { for (int e = tid; e < 16384; e += 512) { const int i = e >> 7, k = e & 127; bf16_t v = 0; if ((i >> 3) == (k >> 3)) v = wsb[(i & 7) * 128 + (k & 7)]; sA[i * MLD + k] = v; } }
            const bf16_t* zv = ZV + 128 * h; const float* gv = P.in[I_VNG] + layer * 512 + 128 * h;
            for (int e = tid; e < 2048; e += 512) {
                const int s = e >> 4, ch = e & 15, row = r0 + s;
                const u32x4 raw = *(const u32x4*)(zv + (size_t)row * 512 + ch * 8);
                const f32x4 va = *(const f32x4*)(vss + (size_t)row * 8), vb = *(const f32x4*)(vss + (size_t)row * 8 + 4);
                const float rs = rsqrtf((((va[0] + va[1]) + (va[2] + va[3])) + ((vb[0] + vb[1]) + (vb[2] + vb[3]))) * (1.0f / 512.0f) + EPS);
                const f32x4 g0 = *(const f32x4*)(gv + ch * 8), g1 = *(const f32x4*)(gv + ch * 8 + 4);
                f32x4 v0, v1;
                v0[0] = bflo(raw.x) * rs * g0[0]; v0[1] = bfhi(raw.x) * rs * g0[1]; v0[2] = bflo(raw.y) * rs * g0[2]; v0[3] = bfhi(raw.y) * rs * g0[3];
                v1[0] = bflo(raw.z) * rs * g1[0]; v1[1] = bfhi(raw.z) * rs * g1[1]; v1[2] = bflo(raw.w) * rs * g1[2]; v1[3] = bfhi(raw.w) * rs * g1[3];
#pragma unroll
                for (int jj = 0; jj < 4; ++jj) { sB[(ch * 8 + jj) * MLD + s] = f2bf(v0[jj]); sB[(ch * 8 + 4 + jj) * MLD + s] = f2bf(v1[jj]); }
                if (sample) { float* o = P.out + O_VS + ((size_t)layer * 1024 + (row - MP)) * 512 + 128 * h + ch * 8; *(f32x4*)o = v0; *(f32x4*)(o + 4) = v1; }
            }
        }
        __syncthreads();
        f32x4 acc[8];
#pragma unroll
        for (int nb = 0; nb < 8; ++nb) acc[nb] = (f32x4){0.f, 0.f, 0.f, 0.f};
        const int lr = lane & 15, kq = lane >> 4;
#pragma unroll
        for (int ks = 0; ks < 4; ++ks) {
            const bf16x8 a = *(const LAS bf16x8*)(sA + (16 * wid + lr) * MLD + ks * 32 + kq * 8);
#pragma unroll
            for (int nb = 0; nb < 8; ++nb) { const bf16x8 b = *(const LAS bf16x8*)(sB + (16 * nb + lr) * MLD + ks * 32 + kq * 8); acc[nb] = __builtin_amdgcn_mfma_f32_16x16x32_bf16(b, a, acc[nb], 0, 0, 0); }
        }
        const int row = 16 * wid + lr, grow = r0 + row;
        if (j < 4) {
#pragma unroll
            for (int nb = 0; nb < 8; ++nb) { u32x2 w; w.x = cvt_pk_bf16(acc[nb][0], acc[nb][1]); w.y = cvt_pk_bf16(acc[nb][2], acc[nb][3]); bf16_t* o = MIX + (size_t)grow * D + 128 * j + 16 * nb + 4 * kq; if (sample) st_wt64(o, w); else *(u32x2*)o = w; }
        } else {
            const int h = j - 4;
            const float bias = P.in[I_BSP][(layer * 4 + h) * 128 + (sample ? (row & 7) : row)];
#pragma unroll
            for (int nb = 0; nb < 8; ++nb) { const int col = 128 * h + 16 * nb + 4 * kq; const u32x2 uu = *(const u32x2*)(ZU + (size_t)grow * 512 + col);
                u32x2 w; w.x = cvt_pk_bf16(bflo(uu.x) * (acc[nb][0] + bias), bfhi(uu.x) * (acc[nb][1] + bias)); w.y = cvt_pk_bf16(bflo(uu.y) * (acc[nb][2] + bias), bfhi(uu.y) * (acc[nb][3] + bias));
                bf16_t* o = MIX + (size_t)grow * D + 512 + col; if (sample) st_wt64(o, w); else *(u32x2*)o = w; }
        }
        if (sample) asm volatile("s_waitcnt vmcnt(0)" ::: "memory");
        __syncthreads();
        if (sample && tid == 0) xb_add(cnt_word(P.ws, layer, 0, (tt - 128) >> 1), 1u);
    }
}

__device__ __forceinline__ void patch_panel_quarter(const Params& P, int layer, int pm, int pn) {
    const int tid = opaque_tid();
    const float* halo = (const float*)(P.ws + WS_HALO); const float* fix = (const float*)(P.ws + WS_FIX);
    const float* cw = P.in[I_CONVW] + (size_t)layer * 3 * FF; const float* cb = P.in[I_CONVB] + (size_t)layer * FF;
    bf16_t* act = (bf16_t*)(P.ws + WS_R1);
    if (tid < 352) {
        const int b = tid / 176, g4 = tid % 176, bidx = 2 * pm + b, c = 704 * pn + 4 * g4;
        if ((bidx & 15) != 0) {
            const f32x4 h2 = *(const f32x4*)(halo + ((size_t)bidx * 2 + 0) * FF + c), h1 = *(const f32x4*)(halo + ((size_t)bidx * 2 + 1) * FF + c);
            const float* f0 = fix + (((size_t)bidx * 2 + 0) * FF + c) * 2; const float* f1 = fix + (((size_t)bidx * 2 + 1) * FF + c) * 2;
            const f32x4 a0 = *(const f32x4*)f0, a1 = *(const f32x4*)(f0 + 4), b0 = *(const f32x4*)f1, b1 = *(const f32x4*)(f1 + 4);
            const f32x4 g0 = (f32x4){a0[0], a0[2], a1[0], a1[2]}, u0 = (f32x4){a0[1], a0[3], a1[1], a1[3]}, g1 = (f32x4){b0[0], b0[2], b1[0], b1[2]}, u1 = (f32x4){b0[1], b0[3], b1[1], b1[3]};
            const f32x4 w0 = *(const f32x4*)(cw + c), w1 = *(const f32x4*)(cw + FF + c), w2 = *(const f32x4*)(cw + 2 * FF + c), bb = *(const f32x4*)(cb + c);
            const f32x4 r0 = gelu4(bb + w0 * h2 + w1 * h1 + w2 * g0) * u0, r1 = gelu4(bb + w0 * h1 + w1 * g0 + w2 * g1) * u1;
            const size_t T = (size_t)128 * bidx;
            u32x2 o; o.x = cvt_pk_bf16(r0[0], r0[1]); o.y = cvt_pk_bf16(r0[2], r0[3]); st_wt64(act + T * FF + c, o);
            o.x = cvt_pk_bf16(r1[0], r1[1]); o.y = cvt_pk_bf16(r1[2], r1[3]); st_wt64(act + (T + 1) * FF + c, o);
        }
    }
    asm volatile("s_waitcnt vmcnt(0)" ::: "memory");
    __syncthreads();
    if (tid == 0) xb_add(pcnt_word(P.ws, layer, pm), 1u);
    wait_count(pcnt_word(P.ws, layer, pm), 4u, (unsigned*)(P.ws + WS_BAR) + XB_TMO);
}

__device__ __forceinline__ void final_phase(const Params& P) {
    const int tid = opaque_tid(), lane = tid & 63, wid = tid >> 6;
    const int gw = blockIdx.x * 8 + wid, NGW = gridDim.x * 8;
    const float* ssf = (const float*)(P.ws + WS_STAT);
    const f32x4* gf = (const f32x4*)P.in[I_FNG];
    const bf16_t* xb = (const bf16_t*)(P.ws + WS_XB);
    for (int row = gw; row < MT; row += NGW) {
        const float rs = rsqrtf(sum16(ssf + (size_t)row * 16) * (1.0f / 1024.0f) + EPS);
        f32x4* yr = (f32x4*)(P.out + (size_t)row * D);
        const u32x2* xr = (const u32x2*)(xb + (size_t)row * D);
#pragma unroll
        for (int j = 0; j < 4; ++j) { const u32x2 r = xr[lane + 64 * j]; const f32x4 v = (f32x4){bflo(r.x), bfhi(r.x), bflo(r.y), bfhi(r.y)}; __builtin_nontemporal_store(v * rs * gf[lane + 64 * j], yr + lane + 64 * j); }
    }
}

__global__ __launch_bounds__(512, 2) void fwd_kernel(Params P) {
    extern __shared__ __attribute__((aligned(16))) unsigned char shm[];
    LAS unsigned char* lds = (LAS unsigned char*)shm;
    cg::grid_group grid = cg::this_grid();
    volatile LAS unsigned* xst = (volatile LAS unsigned*)(lds + 131072);
    if (threadIdx.x == 0) { xst[0] = 0u; xst[1] = 0u; }
    __syncthreads();
    const XcdBarrier xb = xcd_barrier_post((unsigned*)(P.ws + WS_BAR), xst);
    phase0(P, lds);
    grid.sync();
    float* stat = (float*)(P.ws + WS_STAT);
    bf16_t* XB = (bf16_t*)(P.ws + WS_XB);
    unsigned char* R1 = P.ws + WS_R1;
#pragma unroll 1
    for (int l = 0; l < 4; ++l) {
        {
            pg8::Gemm g{XB, (const bf16_t*)(P.ws + WS_WIN) + (size_t)l * INW * D, MT, INW, D};
            pg8::StaticOrder S; S.init(MT, INW, (int)gridDim.x, (int)blockIdx.x);
            EpiA E{stat, (bf16_t*)(R1 + R1_ZP), (float*)(P.ws + WS_VSP),
                   P.out + O_POOLP + (size_t)l * 8 * 15 * 512, P.out + O_POOLS + (size_t)l * 128 * 15 * 512};
            pg8::gemm_phase(lds, g, S, E);
            if (l == 0 && blockIdx.x >= 152) convert_weights(P, lds, 0, 768, 5536, ((int)blockIdx.x - 152) * 8 + (opaque_tid() >> 6), ((int)gridDim.x - 152) * 8);
        }
        xcd_barrier(xb);
        unsigned* tmo = (unsigned*)(P.ws + WS_BAR) + XB_TMO;
        if (blockIdx.x < 16) {
            const int panel = blockIdx.x >> 2;
            wait_count(cnt_word(P.ws, l, 0, panel), 16u, tmo);
            pg8::Gemm g{(const bf16_t*)(R1 + R1_MIX), (const bf16_t*)(P.ws + WS_WOUT) + (size_t)l * D * D, MT, D, D};
            pg8::OneUnit S{64 + panel, (int)(blockIdx.x & 3)};
            { EpiX<false> E{P.in[I_XP], P.in[I_XS], XB, stat}; pg8::gemm_phase(lds, g, S, E); }
        } else mixer_phase(P, l, lds, (int)blockIdx.x - 16, (int)gridDim.x - 16);
        xcd_barrier(xb);
        {
            pg8::Gemm g{(const bf16_t*)(R1 + R1_MIX), (const bf16_t*)(P.ws + WS_WOUT) + (size_t)l * D * D, MP, D, D};
            pg8::StaticOrder S; S.init(MP, D, (int)gridDim.x, (int)blockIdx.x);
            { EpiX<false> E{P.in[I_XP], P.in[I_XS], XB, stat}; pg8::gemm_phase(lds, g, S, E); }
        }
        xcd_barrier(xb);
        {
            pg8::Gemm g{XB, (const bf16_t*)(P.ws + WS_WGU) + (size_t)l * NGU * D, MT, NGU, D};
            pg8::COrder S; S.so.init(MP, NGU, 256, 0); S.c = (int)blockIdx.x; S.seg = 0;
            EpiC E{stat, P.in[I_CONVW] + (size_t)l * 3 * FF, P.in[I_CONVB] + (size_t)l * FF, P.in[I_SCONV] + (size_t)l * 128 * 2 * FF,
                   (bf16_t*)R1, (float*)(P.ws + WS_HALO), (float*)(P.ws + WS_FIX), P.out + O_CONVP + (size_t)l * 8 * 2 * FF, P.out + O_CONVS + (size_t)l * 128 * 2 * FF, cnt_word(P.ws, l, 1, 0)};
            pg8::gemm_phase(lds, g, S, E);
            if (l < 3 && blockIdx.x < 240) convert_weights(P, lds, l + 1, 0, 5536, (int)blockIdx.x * 8 + (opaque_tid() >> 6), 240 * 8);
            if (blockIdx.x >= 240) {
                const int su = (int)blockIdx.x - 240, panel = su >> 2;
                wait_count(cnt_word(P.ws, l, 1, panel), 176u, tmo);
                pg8::Gemm gd{(const bf16_t*)R1, (const bf16_t*)(P.ws + WS_WDN) + (size_t)l * D * FF, MT, D, FF};
                pg8::OneUnit Sd{64 + panel, su & 3};
                EpiX<false> Ed{P.in[I_XP], P.in[I_XS], XB, stat};
                pg8::gemm_phase(lds, gd, Sd, Ed);
                S.seg = 1;
                pg8::gemm_phase(lds, g, S, E);
            }
        }
        xcd_barrier(xb);
        {
            pg8::Gemm g{(const bf16_t*)R1, (const bf16_t*)(P.ws + WS_WDN) + (size_t)l * D * FF, MP, D, FF};
            pg8::StaticOrder S; S.init(MP, D, (int)gridDim.x, (int)blockIdx.x);
            { pg8::Unit u0; if (S.next(0, u0)) patch_panel_quarter(P, l, u0.pm, u0.pn); }
            EpiX<false> E{P.in[I_XP], P.in[I_XS], XB, stat};
            pg8::gemm_phase(lds, g, S, E);
        }
        xcd_barrier(xb);
    }
    final_phase(P);
}

extern "C" void kernel_launch(void* const* d_in, const int* in_sizes, int n_in, void* d_out, int out_size, void* d_ws, size_t ws_size, hipStream_t stream) {
    static int grid_blocks = 0;
    if (grid_blocks == 0) {
        if (n_in != 19 || ws_size < WS_END) { fprintf(stderr, "kernel_launch: unexpected n_in %d or ws_size %zu (< %zu)\n", n_in, ws_size, (size_t)WS_END); grid_blocks = -1; return; }
        int dev = 0, cus = 0, per_cu = 0;
        hipGetDevice(&dev);
        hipDeviceGetAttribute(&cus, hipDeviceAttributeMultiprocessorCount, dev);
        if (hipFuncSetAttribute((const void*)fwd_kernel, hipFuncAttributeMaxDynamicSharedMemorySize, LDS_BYTES) != hipSuccess) { fprintf(stderr, "kernel_launch: hipFuncSetAttribute failed\n"); grid_blocks = -1; return; }
        hipOccupancyMaxActiveBlocksPerMultiprocessor(&per_cu, (const void*)fwd_kernel, 512, LDS_BYTES);
        if (per_cu < 1) { fprintf(stderr, "kernel_launch: occupancy query says %d blocks per CU\n", per_cu); per_cu = 1; }
        (void)hipGetLastError();
        grid_blocks = cus * per_cu;
        if (grid_blocks != 256) { fprintf(stderr, "kernel_launch: this build schedules for exactly 256 workgroups, got %d\n", grid_blocks); grid_blocks = 256; }
    }
    if (grid_blocks < 0) return;
    if (hipMemsetAsync((char*)d_ws + WS_BAR, 0, (XCD_BAR_WORDS + N_CNT * 64) * 4, stream) != hipSuccess) { fprintf(stderr, "kernel_launch: memset of barrier words failed\n"); return; }
    Params p{};
    for (int i = 0; i < 19; ++i) p.in[i] = (const float*)d_in[i];
    p.out = (float*)d_out; p.ws = (unsigned char*)d_ws;
    void* args[] = {&p};
    hipError_t e = hipLaunchCooperativeKernel((const void*)fwd_kernel, dim3(grid_blocks), dim3(512), args, LDS_BYTES, stream);
    if (e != hipSuccess) fprintf(stderr, "cooperative launch failed: %s (grid %d)\n", hipGetErrorString(e), grid_blocks);
}
```

```cpp
#include <hip/hip_runtime.h>
#include <hip/hip_cooperative_groups.h>
#include <cstdio>
namespace cg = cooperative_groups;

#define LAS __attribute__((address_space(3)))
typedef unsigned short bf16_t;
typedef short bf16x8 __attribute__((ext_vector_type(8)));
typedef float f32x4 __attribute__((ext_vector_type(4)));
typedef unsigned u32x4 __attribute__((ext_vector_type(4)));
typedef unsigned u32x2 __attribute__((ext_vector_type(2)));

constexpr int D = 1024, MP = 16384, MT = 17408, INW = 1536, FF = 2816, NGU = 5632;
constexpr float EPS = 1e-6f;

constexpr size_t O_POOLP = 17825792, O_POOLS = 18071552, O_CONVP = 22003712, O_CONVS = 22183936, O_VS = 25067520;
constexpr size_t WS_WIN = 0, WS_WOUT = 12582912, WS_WGU = 20971520, WS_WDN = 67108864, WS_PWT = 90177536, WS_WSB = 90701824,
                 WS_XB = 91226112, WS_R1 = 126877696, WS_HALO = 224919552, WS_FIX = 228005888, WS_STAT = 234178560, WS_VSP = 235292672, WS_BAR = 235849728, WS_END = 235937280;
constexpr size_t R1_ZP = 0, R1_ZU = 17825792, R1_ZV = 35651584, R1_MIX = 53477376;
constexpr int LDS_BYTES = 131072 + 16;

struct Params {
    const float* in[19];
    float* out;
    unsigned char* ws;
};
enum { I_XP = 0, I_XS, I_SPOOL, I_SCONV, I_N1G, I_WIN, I_POOLW, I_PSCALE, I_VNG, I_WSP, I_BSP, I_WOUT, I_N2G, I_WGATE, I_WUP, I_CONVW, I_CONVB, I_WDOWN, I_FNG };

__device__ __forceinline__ unsigned cvt_pk_bf16(float lo, float hi) { unsigned r; asm("v_cvt_pk_bf16_f32 %0, %1, %2" : "=v"(r) : "v"(lo), "v"(hi)); return r; }
__device__ __forceinline__ bf16_t f2bf(float f) { return (bf16_t)(cvt_pk_bf16(f, 0.f) & 0xffffu); }
__device__ __forceinline__ float bf2f(bf16_t b) { return __uint_as_float(((unsigned)b) << 16); }
__device__ __forceinline__ float bflo(unsigned w) { return __uint_as_float(w << 16); }
__device__ __forceinline__ float bfhi(unsigned w) { return __uint_as_float(w & 0xffff0000u); }
__device__ __forceinline__ float gelu_f(float v) {
    const float av = fabsf(v), d = av * 0.2316418882f + 1.0f;
    const float t = __builtin_amdgcn_rcpf(d);
    float q = t * 0.5307027145f + (-0.7265760135f); q = q * t + 0.7107068705f; q = q * t + (-0.142248368f); q = q * t + 0.127414796f; q = q * t;
    const float e = __builtin_amdgcn_exp2f(v * v * (-0.72134752044f));
    const float m = v * (q * e);
    return v < 0.f ? m : v - m;
}
typedef float f32x2 __attribute__((ext_vector_type(2)));
__device__ __forceinline__ f32x2 gelu_pk(f32x2 v) {
    const f32x2 av = __builtin_elementwise_abs(v), d = av * 0.2316418882f + 1.0f;
    f32x2 t; t.x = __builtin_amdgcn_rcpf(d.x); t.y = __builtin_amdgcn_rcpf(d.y);
    f32x2 q = t * 0.5307027145f + (-0.7265760135f); q = q * t + 0.7107068705f; q = q * t + (-0.142248368f); q = q * t + 0.127414796f; q = q * t;
    const f32x2 u = v * 0.8493218003f, s = -(u * u);
    f32x2 e; e.x = __builtin_amdgcn_exp2f(s.x); e.y = __builtin_amdgcn_exp2f(s.y);
    const f32x2 h = 0.5f - q * e;
    return v * 0.5f + av * h;
}
__device__ __forceinline__ f32x4 gelu4(f32x4 v) { const f32x2 a = gelu_pk((f32x2){v[0], v[1]}), b = gelu_pk((f32x2){v[2], v[3]}); return (f32x4){a.x, a.y, b.x, b.y}; }
__device__ __forceinline__ float sum16(const float* p) { const f32x4 a = *(const f32x4*)p, b = *(const f32x4*)(p + 4), c = *(const f32x4*)(p + 8), d = *(const f32x4*)(p + 12); const f32x4 s = (a + b) + (c + d); return (s[0] + s[1]) + (s[2] + s[3]); }
__device__ __forceinline__ float wave_sum(float v) {
#pragma unroll
    for (int o = 1; o < 64; o <<= 1) v += __shfl_xor(v, o);
    return v;
}

__device__ __forceinline__ int opaque_tid() { int t = threadIdx.x; asm volatile("" : "+v"(t)); return t; }

#define XB_TMO      128
#define XB_XCNT(j)  (256  + 64 * (j))
#define XB_XSUB(j)  (1280 + 64 * (j))
#define XB_XGEN(j)  (2304 + 64 * (j))
#define XB_TOP      3328
#define XB_TOPGEN   3392
#define XCD_BAR_WORDS 3456
#define XB_SPIN_CAP (1u << 22)
__device__ __forceinline__ unsigned xb_ld(unsigned* p)              { return __hip_atomic_load(p, __ATOMIC_RELAXED, __HIP_MEMORY_SCOPE_AGENT); }
__device__ __forceinline__ unsigned xb_add(unsigned* p, unsigned v) { return __hip_atomic_fetch_add(p, v, __ATOMIC_RELAXED, __HIP_MEMORY_SCOPE_AGENT); }
__device__ __forceinline__ unsigned xb_xcc_id() { return (unsigned)__builtin_amdgcn_s_getreg((3 << 11) | 20) & 0xFu; }
#define XB_SPIN(cond, bar) do { unsigned _sp = 0; while (cond) { __builtin_amdgcn_s_sleep(1); \
    if ((++_sp & 255u) == 0u) { if (xb_ld(&(bar)[XB_TMO])) break; if (_sp > XB_SPIN_CAP) { atomicAdd(&(bar)[XB_TMO], 1u); break; } } } } while (0)
struct XcdBarrier { unsigned* bar; unsigned x; volatile LAS unsigned* st; };
__device__ __forceinline__ XcdBarrier xcd_barrier_post(unsigned* bar, volatile LAS unsigned* st) {
    XcdBarrier b; b.bar = bar; b.x = xb_xcc_id(); b.st = st;
    if (threadIdx.x == 0) (void)xb_add(&bar[XB_XCNT(b.x)], 1u);
    return b;
}
__device__ __forceinline__ void xcd_barrier_complete(unsigned* bar, unsigned x, unsigned& nloc, unsigned& nx) {
    const unsigned G = gridDim.x * gridDim.y * gridDim.z;
    unsigned sum, cnt, mine, sp = 0u;
    for (;;) {
        sum = 0u; cnt = 0u; mine = 0u;
#pragma unroll
        for (unsigned j = 0; j < 16; ++j) { const unsigned c = xb_ld(&bar[XB_XCNT(j)]); sum += c; cnt += (c > 0u) ? 1u : 0u; mine = (j == x) ? c : mine; }
        if (sum == G) break;
        __builtin_amdgcn_s_sleep(1);
        if ((++sp & 255u) == 0u) { if (xb_ld(&bar[XB_TMO])) break; if (sp > XB_SPIN_CAP) { atomicAdd(&bar[XB_TMO], 1u); break; } }
    }
    nloc = mine > 0u ? mine : 1u; nx = cnt > 0u ? cnt : 1u;
}
__device__ __forceinline__ void xcd_barrier(const XcdBarrier& b) {
    asm volatile("s_waitcnt vmcnt(0)" ::: "memory");
    __syncthreads();
    if (threadIdx.x == 0) {
        unsigned* bar = b.bar;
        __builtin_amdgcn_s_waitcnt(0);
        unsigned nloc = b.st[0], nx = b.st[1];
        if (nloc == 0u) { xcd_barrier_complete(bar, b.x, nloc, nx); b.st[0] = nloc; b.st[1] = nx; }
        const unsigned old = xb_add(&bar[XB_XSUB(b.x)], 1u);
        const unsigned gen = old / nloc;
        if (old + 1u == (gen + 1u) * nloc) {
            __builtin_amdgcn_fence(__ATOMIC_RELEASE, "agent");
            asm volatile("s_waitcnt vmcnt(0)" ::: "memory");
            const unsigned og = xb_add(&bar[XB_TOP], 1u);
            const unsigned tg = og / nx;
            if (og + 1u == (tg + 1u) * nx) xb_add(&bar[XB_TOPGEN], 1u);
            else XB_SPIN(xb_ld(&bar[XB_TOPGEN]) == tg, bar);
            __builtin_amdgcn_fence(__ATOMIC_ACQUIRE, "agent");
            xb_add(&bar[XB_XGEN(b.x)], 1u);
            asm volatile("s_waitcnt vmcnt(0)" ::: "memory");
        } else {
            XB_SPIN(xb_ld(&bar[XB_XGEN(b.x)]) == gen, bar);
            __builtin_amdgcn_fence(__ATOMIC_ACQUIRE, "agent");
            asm volatile("s_waitcnt vmcnt(0)" ::: "memory");
        }
    }
    __syncthreads();
}

constexpr int N_CNT = 32 + 256;
__device__ __forceinline__ unsigned* cnt_word(unsigned char* ws, int layer, int kind, int panel) { return (unsigned*)(ws + WS_BAR) + XCD_BAR_WORDS + ((layer * 2 + kind) * 4 + panel) * 64; }
__device__ __forceinline__ unsigned* pcnt_word(unsigned char* ws, int layer, int pm) { return (unsigned*)(ws + WS_BAR) + XCD_BAR_WORDS + (32 + layer * 64 + pm) * 64; }
__device__ __forceinline__ void st_wt64(void* p, u32x2 w) { __hip_atomic_store((unsigned long long*)p, (unsigned long long)w.x | ((unsigned long long)w.y << 32), __ATOMIC_RELAXED, __HIP_MEMORY_SCOPE_AGENT); }
__device__ __forceinline__ void wait_count(unsigned* word, unsigned need, unsigned* tmo) {
    if (threadIdx.x == 0) {
        unsigned sp = 0;
        while (xb_ld(word) < need) { __builtin_amdgcn_s_sleep(2); if ((++sp & 255u) == 0u) { if (xb_ld(tmo)) break; if (sp > XB_SPIN_CAP) { atomicAdd(tmo, 1u); break; } } }
        __builtin_amdgcn_fence(__ATOMIC_ACQUIRE, "agent");
        asm volatile("s_waitcnt vmcnt(0)" ::: "memory");
    }
    __syncthreads();
}

namespace pg8 {
constexpr int BM = 256, BK = 64, HALF = 128, HTB = HALF * BK * 2, NXCD = 8, WGM = 8;
__device__ __forceinline__ int lds_byte(int r, int c) { const int st = (r >> 4) * 2 + (c >> 5), rr = r & 15, cc = c & 31, ob = rr * 64 + cc * 2; return st * 1024 + (ob ^ (((ob >> 9) & 1) << 5)); }
__device__ __forceinline__ void stage_rc(int b, int& R, int& C) { const int st = b / 1024, sb = b % 1024, swz = sb ^ (((sb >> 9) & 1) << 5); R = (st >> 1) * 16 + swz / 64; C = (st & 1) * 32 + (swz % 64) / 2; }
__device__ __forceinline__ int perm32(int rho) { const int n = rho >> 4, i = rho & 15; return 8 * (i >> 2) + 4 * n + (i & 3); }
struct Unit { int pm, pn; };
struct Gemm { const bf16_t* A; const bf16_t* Bt; int M, N, K; };
struct StaticOrder {
    int nM, nN, nwg, G, c;
    __device__ __forceinline__ void init(int M, int N, int G_, int c_) { nM = M / BM; nN = N / BM; nwg = nM * nN; G = G_; c = c_; }
    __device__ __forceinline__ void map(int L, Unit& u) const {
        int wgid = L; { const int q = nwg / NXCD, r = nwg % NXCD, xcd = wgid % NXCD, off = wgid / NXCD; wgid = (xcd < r ? xcd * (q + 1) : r * (q + 1) + (xcd - r) * q) + off; }
        const int nig = WGM * nN, gid = wgid / nig, fm = gid * WGM, gsz = (nM - fm) < WGM ? (nM - fm) : WGM;
        u.pm = fm + ((wgid % nig) % gsz); u.pn = (wgid % nig) / gsz;
    }
    __device__ __forceinline__ bool next(int i, Unit& u) const { const long L = (long)i * G + c; if (L >= nwg) return false; map((int)L, u); return true; }
};
struct OneUnit { int pm, pn; __device__ __forceinline__ bool next(int i, Unit& u) const { if (i) return false; u.pm = pm; u.pn = pn; return true; } };
struct COrder {
    StaticOrder so; int c, seg;
    __device__ __forceinline__ bool next(int i, Unit& u) const {
        if (c < 128) { if (i > 5) return false; so.map(i * 256 + c, u); return true; }
        if (c < 216) { if (i > 5) return false; if (i == 0) { const int su = c - 128; u.pm = 64 + su / 22; u.pn = su % 22; return true; } so.map((i - 1) * 256 + c, u); return true; }
        if (c < 232) { if (i > 5) return false; so.map(i < 5 ? i * 256 + c : 1024 + 240 + (c - 216), u); return true; }
        if (c < 240) { if (i > 4) return false; so.map(i * 256 + c, u); return true; }
        if (seg == 0) { if (i > 0) return false; so.map(c, u); return true; }
        if (i > 2) return false; so.map((i + 1) * 256 + c, u); return true;
    }
};

template <class Epi, class Sched>
__device__ __forceinline__ void gemm_phase(LAS unsigned char* lds, const Gemm g, const Sched& S, const Epi& E) {
    const int tid = opaque_tid(), wid = __builtin_amdgcn_readfirstlane(tid >> 6), lane = tid & 63, wr = wid >> 2, wc = wid & 3, fr = lane & 15, fq = lane >> 4;
    const int K = g.K, nt = K / BK;
    unsigned voffA[2], voffB[2];
#pragma unroll
    for (int i = 0; i < 2; ++i) { int R, C; stage_rc(tid * 16 + i * 8192, R, C); const int Rb = (R & ~31) + perm32(R & 31);
        const int Ra = Epi::AROWPERM ? (8 * (16 * (R >> 6) + (R & 15)) + ((R >> 4) & 3)) : R;
        voffA[i] = (unsigned)(Ra * K + C) * 2u; voffB[i] = (unsigned)(Rb * K + C) * 2u; }
    const size_t kstep = (size_t)(BK * 2);
    const size_t hstepB = (size_t)HALF * K * 2;
    const size_t hstepA = Epi::AROWPERM ? (size_t)4 * K * 2 : hstepB;
    const size_t tstep = 2 * hstepB;
    const unsigned ldsw = (unsigned)wid * 1024u;
    const int aoff = lds_byte(wr * 64 + fr, fq * 8), boff = lds_byte(wc * 32 + fr, fq * 8);
#define PG8_SA(b, h) (((b) * 2 + (h)) * HTB)
#define PG8_SB(b, h) ((4 + (b) * 2 + (h)) * HTB)
#define PG8_STAGE(bufoff, gbase, voff) do { _Pragma("unroll") for (int _i = 0; _i < 2; ++_i) \
        __builtin_amdgcn_global_load_lds((const unsigned*)((const char*)(gbase) + (voff)[_i]), (LAS unsigned*)(lds + (bufoff) + ldsw + _i * 8192), 16, 0, 0); } while (0)
#define PG8_LDA(dst, b, h) do { _Pragma("unroll") for (int m = 0; m < 4; ++m) _Pragma("unroll") for (int k = 0; k < 2; ++k) dst[m][k] = *(const LAS bf16x8*)(lds + PG8_SA(b, h) + aoff + m * 2048 + k * 1024); } while (0)
#define PG8_LDB(dst, b, h) do { _Pragma("unroll") for (int n = 0; n < 2; ++n) _Pragma("unroll") for (int k = 0; k < 2; ++k) dst[n][k] = *(const LAS bf16x8*)(lds + PG8_SB(b, h) + boff + n * 2048 + k * 1024); } while (0)
#define PG8_MMA(ai, bj, At, Bt) do { __builtin_amdgcn_s_setprio(1); _Pragma("unroll") for (int m = 0; m < 4; ++m) _Pragma("unroll") for (int n = 0; n < 2; ++n) _Pragma("unroll") for (int k = 0; k < 2; ++k) \
        acc[ai][bj][m][n] = __builtin_amdgcn_mfma_f32_16x16x32_bf16(Bt[n][k], At[m][k], acc[ai][bj][m][n], 0, 0, 0); __builtin_amdgcn_s_setprio(0); } while (0)
#define PG8_WAIT_V(n) asm volatile("s_waitcnt vmcnt(" #n ")" ::: "memory")
#define PG8_WAIT_L(n) asm volatile("s_waitcnt lgkmcnt(" #n ")" ::: "memory")
#define PG8_BAR __builtin_amdgcn_s_barrier()
#define PG8_SCHED __builtin_amdgcn_sched_barrier(0)
    Unit cur, nxt; int ui = 0;
    if (!S.next(0, cur)) return;
    f32x4 acc[2][2][4][2];
    typename Epi::Raw raw;
    if constexpr (Epi::HAS_INIT) E.load_init(raw, cur, wr, wc);
    bf16x8 At[4][2], B0[2][2], B1[2][2];
    const char* cA = (const char*)g.A + (size_t)cur.pm * tstep; const char* cB = (const char*)g.Bt + (size_t)cur.pn * tstep;
    PG8_STAGE(PG8_SB(0, 0), cB, voffB); PG8_STAGE(PG8_SA(0, 0), cA, voffA); PG8_STAGE(PG8_SB(0, 1), cB + hstepB, voffB); PG8_STAGE(PG8_SA(0, 1), cA + hstepA, voffA);
    if (wr == 1) PG8_BAR;
    PG8_WAIT_V(4); PG8_BAR;
    PG8_STAGE(PG8_SB(1, 0), cB + kstep, voffB); PG8_STAGE(PG8_SA(1, 0), cA + kstep, voffA); PG8_STAGE(PG8_SB(1, 1), cB + hstepB + kstep, voffB);
    PG8_WAIT_V(6); PG8_BAR;
    if constexpr (Epi::HAS_INIT) E.apply_init(acc, raw);
    else {
#pragma unroll
        for (int a = 0; a < 2; ++a)
#pragma unroll
            for (int b = 0; b < 2; ++b)
#pragma unroll
                for (int m = 0; m < 4; ++m)
#pragma unroll
                    for (int n = 0; n < 2; ++n) acc[a][b][m][n] = (f32x4){0.f, 0.f, 0.f, 0.f};
    }
    for (;;) {
        const bool has_next = S.next(ui + 1, nxt);
        const char* nA = has_next ? (const char*)g.A + (size_t)nxt.pm * tstep : cA; const char* nB = has_next ? (const char*)g.Bt + (size_t)nxt.pn * tstep : cB;
        for (int t = 0; t < nt; t += 2) {
            const bool last = (t == nt - 2);
            const char* a1 = cA + (size_t)(t + 1) * kstep;
            const char* a2 = last ? nA : cA + (size_t)(t + 2) * kstep; const char* b2 = last ? nB : cB + (size_t)(t + 2) * kstep;
            const char* a3 = a2 + kstep; const char* b3 = b2 + kstep;
            PG8_LDB(B0, 0, 0); PG8_SCHED; PG8_LDA(At, 0, 0); PG8_STAGE(PG8_SA(1, 1), a1 + hstepA, voffA);
            PG8_WAIT_L(8); PG8_BAR; PG8_WAIT_L(0); PG8_MMA(0, 0, At, B0); PG8_BAR; PG8_SCHED;
            PG8_LDB(B1, 0, 1); PG8_STAGE(PG8_SB(0, 0), b2, voffB);
            PG8_BAR; PG8_WAIT_L(0); PG8_MMA(0, 1, At, B1); PG8_BAR;
            PG8_LDA(At, 0, 1); PG8_STAGE(PG8_SA(0, 0), a2, voffA);
            PG8_BAR; PG8_WAIT_L(0); PG8_MMA(1, 0, At, B0); PG8_BAR; PG8_SCHED;
            PG8_STAGE(PG8_SB(0, 1), b2 + hstepB, voffB);
            PG8_WAIT_V(6); PG8_BAR; PG8_MMA(1, 1, At, B1); PG8_BAR;
            PG8_LDB(B0, 1, 0); PG8_SCHED; PG8_LDA(At, 1, 0); PG8_STAGE(PG8_SA(0, 1), a2 + hstepA, voffA);
            PG8_WAIT_L(8); PG8_BAR; PG8_WAIT_L(0); PG8_MMA(0, 0, At, B0); PG8_BAR; PG8_SCHED;
            PG8_LDB(B1, 1, 1); PG8_STAGE(PG8_SB(1, 0), b3, voffB);
            PG8_BAR; PG8_WAIT_L(0); PG8_MMA(0, 1, At, B1); PG8_BAR;
            PG8_LDA(At, 1, 1); PG8_STAGE(PG8_SA(1, 0), a3, voffA);
            PG8_BAR; PG8_WAIT_L(0); PG8_MMA(1, 0, At, B0); PG8_BAR; PG8_SCHED;
            PG8_STAGE(PG8_SB(1, 1), b3 + hstepB, voffB);
            PG8_WAIT_V(6); PG8_BAR; PG8_MMA(1, 1, At, B1); PG8_BAR;
        }
        E(acc, cur, wr, wc, fr, fq);
        if (!has_next) break;
        if constexpr (Epi::HAS_INIT) { E.load_init(raw, nxt, wr, wc); E.apply_init(acc, raw); }
        else {
#pragma unroll
            for (int a = 0; a < 2; ++a)
#pragma unroll
                for (int b = 0; b < 2; ++b)
#pragma unroll
                    for (int m = 0; m < 4; ++m)
#pragma unroll
                        for (int n = 0; n < 2; ++n) acc[a][b][m][n] = (f32x4){0.f, 0.f, 0.f, 0.f};
        }
        cur = nxt; cA = nA; cB = nB; ++ui;
    }
    PG8_WAIT_V(0);
    if (wr == 0) PG8_BAR;
    PG8_BAR;
#undef PG8_SA
#undef PG8_SB
#undef PG8_STAGE
#undef PG8_LDA
#undef PG8_LDB
#undef PG8_MMA
#undef PG8_WAIT_V
#undef PG8_WAIT_L
#undef PG8_BAR
#undef PG8_SCHED
}
}

struct NoRaw {};
struct EpiA {
    static constexpr bool AROWPERM = false, HAS_INIT = false; typedef NoRaw Raw;
    const float* ss1; bf16_t* zp; float* vss; float* poolP; float* poolS;
    __device__ __forceinline__ void operator()(const f32x4 (&acc)[2][2][4][2], const pg8::Unit& u, int wr, int wc, int fr_, int fq_) const {
        const int lane_ = opaque_tid() & 63, fr = lane_ & 15, fq = lane_ >> 4;
        const int row0 = u.pm * 256 + wr * 64 + fr;
        const int kind = u.pn >> 1;
        const int colt = (u.pn & 1) * 256 + wc * 32 + 8 * fq;
        bf16_t* base = zp + (size_t)kind * ((size_t)MT * 512);
        float my0, my1;
        { const int k0 = 2 * fq, k1 = k0 + 1;
          my0 = rsqrtf(sum16(ss1 + (size_t)(row0 + 128 * (k0 >> 2) + 16 * (k0 & 3)) * 16) * (1.0f / 1024.0f) + EPS);
          my1 = rsqrtf(sum16(ss1 + (size_t)(row0 + 128 * (k1 >> 2) + 16 * (k1 & 3)) * 16) * (1.0f / 1024.0f) + EPS); }
        float rsv[8];
#pragma unroll
        for (int k = 0; k < 8; ++k) rsv[k] = __shfl((k & 1) ? my1 : my0, (k >> 1) * 16 + fr);
#pragma unroll
        for (int ai = 0; ai < 2; ++ai)
#pragma unroll
            for (int m = 0; m < 4; ++m) {
                const int row = row0 + ai * 128 + m * 16;
                const float rs = rsv[ai * 4 + m];
                float ssum = 0.f;
#pragma unroll
                for (int bj = 0; bj < 2; ++bj) {
                    f32x4 v0 = acc[ai][bj][m][0] * rs, v1 = acc[ai][bj][m][1] * rs;
                    const int col = colt + bj * 128;
                    if (kind == 0) {
                        if (row < MP) { const int t = row & 2047; if (t >= 2033) { float* o = poolP + ((size_t)(row >> 11) * 15 + (t - 2033)) * 512 + col; *(f32x4*)o = v0; *(f32x4*)(o + 4) = v1; } }
                        else { const int rr = row - MP; float* o = poolS + ((size_t)(rr >> 3) * 15 + 7 + (rr & 7)) * 512 + col; *(f32x4*)o = v0; *(f32x4*)(o + 4) = v1; }
                    } else {
                        v0 = gelu4(v0); v1 = gelu4(v1);
                        if (kind == 2) ssum += (v0[0] * v0[0] + v0[1] * v0[1]) + (v0[2] * v0[2] + v0[3] * v0[3]) + (v1[0] * v1[0] + v1[1] * v1[1]) + (v1[2] * v1[2] + v1[3] * v1[3]);
                    }
                    u32x4 w; w.x = cvt_pk_bf16(v0[0], v0[1]); w.y = cvt_pk_bf16(v0[2], v0[3]); w.z = cvt_pk_bf16(v1[0], v1[1]); w.w = cvt_pk_bf16(v1[2], v1[3]);
                    *(u32x4*)(base + (size_t)row * 512 + col) = w;
                }
                if (kind == 2) { ssum += __shfl_xor(ssum, 16); ssum += __shfl_xor(ssum, 32); if (fq == 0) vss[(size_t)row * 8 + (u.pn & 1) * 4 + wc] = ssum; }
            }
    }
};
template <bool FROM_IN> struct EpiX {
    static constexpr bool AROWPERM = false, HAS_INIT = !FROM_IN;
    struct Raw { u32x4 r[2][4][2]; };
    const float* xin_p; const float* xin_s; bf16_t* xb; float* ssout;
    __device__ __forceinline__ void load_init(Raw& raw, const pg8::Unit& u, int wr, int wc) const {
        const int lane_ = opaque_tid() & 63, fr = lane_ & 15, fq = lane_ >> 4;
        const bf16_t* p = xb + (size_t)(u.pm * 256 + wr * 64 + fr) * D + u.pn * 256 + wc * 32 + 8 * fq;
#pragma unroll
        for (int ai = 0; ai < 2; ++ai)
#pragma unroll
            for (int m = 0; m < 4; ++m)
#pragma unroll
                for (int bj = 0; bj < 2; ++bj) raw.r[ai][m][bj] = *(const u32x4*)(p + (size_t)(ai * 128 + m * 16) * D + bj * 128);
    }
    __device__ __forceinline__ void apply_init(f32x4 (&acc)[2][2][4][2], const Raw& raw) const {
#pragma unroll
        for (int ai = 0; ai < 2; ++ai)
#pragma unroll
            for (int m = 0; m < 4; ++m)
#pragma unroll
                for (int bj = 0; bj < 2; ++bj) {
                    const u32x4 r = raw.r[ai][m][bj]; acc[ai][bj][m][0] = (f32x4){bflo(r.x), bfhi(r.x), bflo(r.y), bfhi(r.y)}; acc[ai][bj][m][1] = (f32x4){bflo(r.z), bfhi(r.z), bflo(r.w), bfhi(r.w)};
                }
    }
    __device__ __forceinline__ void operator()(const f32x4 (&acc)[2][2][4][2], const pg8::Unit& u, int wr, int wc, int fr_, int fq_) const {
        const int lane_ = opaque_tid() & 63, fr = lane_ & 15, fq = lane_ >> 4;
        const int row0 = u.pm * 256 + wr * 64 + fr, col0 = u.pn * 256 + wc * 32 + 8 * fq;
#pragma unroll
        for (int ai = 0; ai < 2; ++ai)
#pragma unroll
            for (int m = 0; m < 4; ++m) {
                const int row = row0 + ai * 128 + m * 16;
                float ssum = 0.f;
#pragma unroll
                for (int bj = 0; bj < 2; ++bj) {
                    const int col = col0 + bj * 128;
                    f32x4 v0 = acc[ai][bj][m][0], v1 = acc[ai][bj][m][1];
                    if constexpr (FROM_IN) { const float* xo = row < MP ? xin_p + (size_t)row * D : xin_s + (size_t)(row - MP) * D; v0 += *(const f32x4*)(xo + col); v1 += *(const f32x4*)(xo + col + 4); }
                    ssum += (v0[0] * v0[0] + v0[1] * v0[1]) + (v0[2] * v0[2] + v0[3] * v0[3]) + (v1[0] * v1[0] + v1[1] * v1[1]) + (v1[2] * v1[2] + v1[3] * v1[3]);
                    u32x4 w; w.x = cvt_pk_bf16(v0[0], v0[1]); w.y = cvt_pk_bf16(v0[2], v0[3]); w.z = cvt_pk_bf16(v1[0], v1[1]); w.w = cvt_pk_bf16(v1[2], v1[3]);
                    *(u32x4*)(xb + (size_t)row * D + col) = w;
                }
                ssum += __shfl_xor(ssum, 16); ssum += __shfl_xor(ssum, 32); if (fq == 0) ssout[(size_t)row * 16 + u.pn * 4 + wc] = ssum;
            }
    }
};
struct EpiC {
    static constexpr bool AROWPERM = true, HAS_INIT = false; typedef NoRaw Raw;
    const float* ss2; const float* cw; const float* cb; const float* sconv; bf16_t* act; float* halo; float* fix; float* convP; float* convS; unsigned* actcnt;
    __device__ __forceinline__ void operator()(const f32x4 (&acc)[2][2][4][2], const pg8::Unit& u, int wr, int wc, int fr_, int fq_) const {
        const int lane_ = opaque_tid() & 63, fr = lane_ & 15, fq = lane_ >> 4;
        const int q = 16 * wr + fr;
        const int tok0 = u.pm * 256 + 8 * q;
        const bool sample = (u.pm * 256) >= MP;
        const float my0 = rsqrtf(sum16(ss2 + (size_t)(tok0 + 2 * fq) * 16) * (1.0f / 1024.0f) + EPS), my1 = rsqrtf(sum16(ss2 + (size_t)(tok0 + 2 * fq + 1) * 16) * (1.0f / 1024.0f) + EPS);
        float rs[8];
#pragma unroll
        for (int k = 0; k < 8; ++k) rs[k] = __shfl((k & 1) ? my1 : my0, (k >> 1) * 16 + fr);
        const int cgl = u.pn * 128 + wc * 32 + 8 * fq;
        const bool first = (fr == 0), lastl = (fr == 15);
        const int bidx = 2 * u.pm + wr;
        const bool seqstart = (bidx & 15) == 0;
        const bool deferred = !sample && first && !seqstart;
        const int sb = sample ? ((tok0 - MP) >> 3) : 0;
#pragma unroll
        for (int n = 0; n < 2; ++n) {
            const int c = cgl + 4 * n;
            const f32x4 w0 = *(const f32x4*)(cw + c), w1 = *(const f32x4*)(cw + FF + c), w2 = *(const f32x4*)(cw + 2 * FF + c), bb = *(const f32x4*)(cb + c);
            const f32x4 g6 = acc[1][0][2][n] * rs[6], g7 = acc[1][0][3][n] * rs[7];
            f32x4 gm1, gm2;
            if (sample) { gm2 = *(const f32x4*)(sconv + ((size_t)sb * 2 + 0) * FF + c); gm1 = *(const f32x4*)(sconv + ((size_t)sb * 2 + 1) * FF + c); }
            else {
#pragma unroll
                for (int j = 0; j < 4; ++j) { gm1[j] = __shfl_up(g7[j], 1, 16); gm2[j] = __shfl_up(g6[j], 1, 16); }
                if (first) { gm1 = (f32x4){0.f, 0.f, 0.f, 0.f}; gm2 = gm1; }
            }
#pragma unroll
            for (int k = 0; k < 8; ++k) {
                const f32x4 gk = acc[k >> 2][0][k & 3][n] * rs[k], uk = acc[k >> 2][1][k & 3][n] * rs[k];
                const f32x4 cv = bb + w0 * gm2 + w1 * gm1 + w2 * gk;
                const f32x4 a = gelu4(cv) * uk;
                if (!(deferred && k < 2)) { u32x2 w; w.x = cvt_pk_bf16(a[0], a[1]); w.y = cvt_pk_bf16(a[2], a[3]); if (sample) st_wt64(act + (size_t)(tok0 + k) * FF + c, w); else *(u32x2*)(act + (size_t)(tok0 + k) * FF + c) = w; }
                if (k < 2 && deferred) { float* o = fix + (((size_t)bidx * 2 + k) * FF + c) * 2;
                    *(f32x4*)o = (f32x4){gk[0], uk[0], gk[1], uk[1]}; *(f32x4*)(o + 4) = (f32x4){gk[2], uk[2], gk[3], uk[3]}; }
                gm2 = gm1; gm1 = gk;
            }
            if (!sample) {
                if (lastl) {
                    const int hb = bidx + 1;
                    *(f32x4*)(halo + ((size_t)hb * 2 + 0) * FF + c) = g6; *(f32x4*)(halo + ((size_t)hb * 2 + 1) * FF + c) = g7;
                    if ((hb & 15) == 0) { const int b = (hb >> 4) - 1; *(f32x4*)(convP + ((size_t)b * 2 + 0) * FF + c) = g6; *(f32x4*)(convP + ((size_t)b * 2 + 1) * FF + c) = g7; }
                }
            } else { *(f32x4*)(convS + ((size_t)sb * 2 + 0) * FF + c) = g6; *(f32x4*)(convS + ((size_t)sb * 2 + 1) * FF + c) = g7; }
        }
        if (sample) { asm volatile("s_waitcnt vmcnt(0)" ::: "memory"); if (lane_ == 0) xb_add(actcnt + (u.pm - 64) * 64, 1u); }
    }
};

struct TDesc { const float* W; const float* gk; const float* gn; bf16_t* WT; int N, ldk, dst_row0, k0, n0; };
struct TRegs { f32x4 v[8]; };
__device__ __forceinline__ void t_load(const TDesc& d, TRegs& t, int lane) {
    const int c4 = lane & 7;
    f32x4 gnv = (f32x4){1.f, 1.f, 1.f, 1.f};
    if (d.gn) gnv = *(const f32x4*)(d.gn + d.n0 + 4 * c4);
#pragma unroll
    for (int i = 0; i < 8; ++i) { const int kk = 8 * i + (lane >> 3); f32x4 v = __builtin_nontemporal_load((const f32x4*)(d.W + (size_t)(d.k0 + kk) * d.N + d.n0 + 4 * c4)) * gnv; if (d.gk) v *= d.gk[d.k0 + kk]; t.v[i] = v; }
}
__device__ __forceinline__ void t_store(const TDesc& d, const TRegs& t, LAS float* scr, int lane) {
    const int c4 = lane & 7;
#pragma unroll
    for (int i = 0; i < 8; ++i) { const int kk = 8 * i + (lane >> 3); LAS float* q = scr + kk * 33 + 4 * c4; q[0] = t.v[i][0]; q[1] = t.v[i][1]; q[2] = t.v[i][2]; q[3] = t.v[i][3]; }
    asm volatile("s_waitcnt lgkmcnt(0)" ::: "memory");
    const int c = lane & 7;
#pragma unroll
    for (int j = 0; j < 4; ++j) { const int n = (lane >> 3) + 8 * j; const LAS float* sp = scr + (8 * c) * 33 + n;
        u32x4 o; o.x = cvt_pk_bf16(sp[0 * 33], sp[1 * 33]); o.y = cvt_pk_bf16(sp[2 * 33], sp[3 * 33]); o.z = cvt_pk_bf16(sp[4 * 33], sp[5 * 33]); o.w = cvt_pk_bf16(sp[6 * 33], sp[7 * 33]);
        *(u32x4*)(d.WT + (size_t)(d.dst_row0 + n) * d.ldk + d.k0 + 8 * c) = o; }
    asm volatile("s_waitcnt lgkmcnt(0)" ::: "memory");
}
__device__ __forceinline__ void t_decode(const Params& P, int it, TDesc& d) {
    const int l = it / 5536; int r = it % 5536;
    d.gk = nullptr; d.gn = nullptr;
    if (r < 768) { const int kb = r / 48, nb = r % 48; d.W = P.in[I_WIN] + (size_t)l * D * INW; d.N = INW; d.gk = P.in[I_N1G] + l * D; d.WT = (bf16_t*)(P.ws + WS_WIN) + (size_t)l * INW * D; d.ldk = D; d.dst_row0 = 32 * nb; d.k0 = 64 * kb; d.n0 = 32 * nb; return; } r -= 768;
    if (r < 512) { const int kb = r / 32, nb = r % 32; d.W = P.in[I_WOUT] + (size_t)l * D * D; d.N = D; d.WT = (bf16_t*)(P.ws + WS_WOUT) + (size_t)l * D * D; d.ldk = D; d.dst_row0 = 32 * nb; d.k0 = 64 * kb; d.n0 = 32 * nb; return; } r -= 512;
    if (r < 2816) { const int up = r >= 1408; if (up) r -= 1408; const int kb = r / 88, nb = r % 88, n0 = 32 * nb; d.W = (up ? P.in[I_WUP] : P.in[I_WGATE]) + (size_t)l * D * FF; d.N = FF; d.gk = P.in[I_N2G] + l * D;
        d.WT = (bf16_t*)(P.ws + WS_WGU) + (size_t)l * NGU * D; d.ldk = D; d.dst_row0 = 256 * (n0 >> 7) + 128 * up + (n0 & 127); d.k0 = 64 * kb; d.n0 = n0; return; } r -= 2816;
    if (r < 1408) { const int kb = r / 32, nb = r % 32; d.W = P.in[I_WDOWN] + (size_t)l * FF * D; d.N = D; d.WT = (bf16_t*)(P.ws + WS_WDN) + (size_t)l * D * FF; d.ldk = FF; d.dst_row0 = 32 * nb; d.k0 = 64 * kb; d.n0 = 32 * nb; return; } r -= 1408;
    { const int gi = r >> 3, rr = r & 7, kb = rr >> 2, nb = rr & 3; d.W = P.in[I_POOLW] + (size_t)(l * 4 + gi) * 16384; d.N = 128; d.gn = P.in[I_PSCALE] + l * 512 + gi * 128;
      d.WT = (bf16_t*)(P.ws + WS_PWT) + (size_t)(l * 4 + gi) * 16384; d.ldk = 128; d.dst_row0 = 32 * nb; d.k0 = 64 * kb; d.n0 = 32 * nb; }
}

__device__ __forceinline__ void convert_weights(const Params& P, LAS unsigned char* lds, int layer, int lo, int hi, int gw, int NGW) {
    const int tid = opaque_tid(), lane = tid & 63, wid = tid >> 6;
    LAS float* scr = (LAS float*)(lds + wid * 8704);
    const int base = layer * 5536;
    int it = lo + gw;
    TDesc dc, dn; TRegs tc, tn;
    if (it < hi) { t_decode(P, base + it, dc); t_load(dc, tc, lane); }
    while (it < hi) {
        const int itn = it + NGW; const bool hn = itn < hi;
        if (hn) { t_decode(P, base + itn, dn); t_load(dn, tn, lane); }
        t_store(dc, tc, scr, lane);
        if (hn) { dc = dn; tc = tn; }
        it = itn;
    }
}

__device__ __forceinline__ void phase0(const Params& P, LAS unsigned char* lds) {
    const int tid = opaque_tid(), lane = tid & 63, wid = tid >> 6;
    const int gw = blockIdx.x * 8 + wid, NGW = gridDim.x * 8;
    const int gtid = blockIdx.x * 512 + tid, NT = gridDim.x * 512;
    float* stat = (float*)(P.ws + WS_STAT);
    bf16_t* xb = (bf16_t*)(P.ws + WS_XB);
    for (int row = gw; row < MT; row += NGW) {
        const float* xr = row < MP ? P.in[I_XP] + (size_t)row * D : P.in[I_XS] + (size_t)(row - MP) * D;
        f32x4 v[4]; float s = 0.f;
#pragma unroll
        for (int j = 0; j < 4; ++j) { v[j] = __builtin_nontemporal_load((const f32x4*)xr + lane + 64 * j); s += (v[j][0] * v[j][0] + v[j][1] * v[j][1]) + (v[j][2] * v[j][2] + v[j][3] * v[j][3]); }
        s = wave_sum(s);
#pragma unroll
        for (int j = 0; j < 4; ++j) { u32x2 w; w.x = cvt_pk_bf16(v[j][0], v[j][1]); w.y = cvt_pk_bf16(v[j][2], v[j][3]); ((u32x2*)(xb + (size_t)row * D))[lane + 64 * j] = w; }
        if (lane < 16) stat[(size_t)row * 16 + lane] = lane == 0 ? s : 0.f;
    }
    convert_weights(P, lds, 0, 0, 768, gw, NGW);
    { const f32x4* sp = (const f32x4*)P.in[I_SPOOL]; f32x4* o = (f32x4*)(P.out + O_POOLS);
      for (int i = gtid; i < 4 * 128 * 7 * 128; i += NT) { const int c4 = i & 127, rr = (i >> 7) % 7, lb = (i >> 7) / 7; o[((size_t)lb * 15 + rr) * 128 + c4] = sp[((size_t)lb * 15 + rr + 8) * 128 + c4]; } }
    { bf16_t* WSB = (bf16_t*)(P.ws + WS_WSB); const float* wsp = P.in[I_WSP];
      for (int i = gtid; i < 4 * 4 * 128 * 128; i += NT) { const int s = i & 127, t = (i >> 7) & 127; WSB[i] = (s <= t) ? f2bf(wsp[i]) : (bf16_t)0; } }
}

constexpr int MLD = 136;
template <int W> __device__ __forceinline__ void pool_sample_stage(const Params& P, int layer, int gi, int tt, LAS bf16_t* sA, int tid) {
    const bf16_t* ZP = (const bf16_t*)(P.ws + WS_R1 + R1_ZP);
    const int r0 = tt * 128;
#pragma unroll 2
    for (int q_ = 0; q_ < 4; ++q_) {
        const int pi = tid + 512 * q_;
        const int c = pi & 127, bl = pi >> 7; const int b = (tt - 128) * 16 + bl;
        const float* sp = P.in[I_SPOOL] + (((size_t)layer * 128 + b) * 15) * 512 + 128 * gi + c;
        float full[23];
#pragma unroll
        for (int i = 0; i < 15; ++i) full[i] = (i >= 16 - W) ? sp[(size_t)i * 512] : 0.f;
        const bf16_t* zp = ZP + (size_t)(r0 + bl * 8) * 512 + 128 * gi + c;
#pragma unroll
        for (int t = 0; t < 8; ++t) full[15 + t] = bf2f(zp[(size_t)t * 512]);
#pragma unroll
        for (int t = 0; t < 8; ++t) { float s = 0.f;
#pragma unroll
            for (int i = 0; i < W; ++i) s += full[15 + t - i];
            sA[(bl * 8 + t) * MLD + c] = f2bf(s * (1.0f / W) - full[15 + t]); }
    }
}

__device__ __forceinline__ void mixer_phase(const Params& P, int layer, LAS unsigned char* lds, int c2, int G2) {
    const int tid = opaque_tid(), lane = tid & 63, wid = tid >> 6;
    LAS bf16_t* sA = (LAS bf16_t*)lds;
    LAS bf16_t* sB = (LAS bf16_t*)(lds + 34816);
    LAS bf16_t* sP = (LAS bf16_t*)(lds + 69632);
    const bf16_t* ZP = (const bf16_t*)(P.ws + WS_R1 + R1_ZP); const bf16_t* ZU = (const bf16_t*)(P.ws + WS_R1 + R1_ZU); const bf16_t* ZV = (const bf16_t*)(P.ws + WS_R1 + R1_ZV);
    bf16_t* MIX = (bf16_t*)(P.ws + WS_R1 + R1_MIX);
    const float* vss = (const float*)(P.ws + WS_VSP);
    for (int it2 = c2; it2 < 1088; it2 += G2) {
        const int it = it2 < 64 ? 1024 + it2 : it2 - 64;
        const int tt = it >> 3, j = it & 7, r0 = tt * 128;
        const bool sample = tt >= 128;
        if (j < 4) {
            const int gi = j;
            const bf16_t* pw = (const bf16_t*)(P.ws + WS_PWT) + (size_t)(layer * 4 + gi) * 16384;
#pragma unroll
            for (int q_ = 0; q_ < 4; ++q_) { const int e = tid + 512 * q_; const int n = e >> 4, ch = e & 15; *(LAS u32x4*)(sB + n * MLD + ch * 8) = *(const u32x4*)(pw + n * 128 + ch * 8); }
            if (!sample) {
                const bf16_t* zp = ZP + 128 * gi;
#pragma unroll
                for (int q_ = 0; q_ < 5; ++q_) { const int e = tid + 512 * q_; if (e >= 143 * 16) break; const int row = e >> 4, ch = e & 15; const int grow = r0 - 15 + row; u32x4 v = (u32x4){0u, 0u, 0u, 0u};
                    if (row >= 15 || (tt & 15) != 0) v = *(const u32x4*)(zp + (size_t)grow * 512 + ch * 8);
                    *(LAS u32x4*)(sP + row * 128 + ch * 8) = v; }
                __syncthreads();
                const int ch = tid & 15, seg = tid >> 4; const int w = 2 << gi;
                const int tpos0 = (r0 & 2047) + seg * 4;
                float sm[8];
#pragma unroll
                for (int q = 0; q < 8; ++q) sm[q] = 0.f;
                for (int i = 1; i < w; ++i) { const u32x4 pr = *(const LAS u32x4*)(sP + (15 + seg * 4 - i) * 128 + ch * 8);
                    sm[0] += bflo(pr.x); sm[1] += bfhi(pr.x); sm[2] += bflo(pr.y); sm[3] += bfhi(pr.y); sm[4] += bflo(pr.z); sm[5] += bfhi(pr.z); sm[6] += bflo(pr.w); sm[7] += bfhi(pr.w); }
#pragma unroll
                for (int rr = 0; rr < 4; ++rr) {
                    const int row = seg * 4 + rr;
                    const u32x4 pr = *(const LAS u32x4*)(sP + (15 + row) * 128 + ch * 8);
                    float pv[8] = {bflo(pr.x), bfhi(pr.x), bflo(pr.y), bfhi(pr.y), bflo(pr.z), bfhi(pr.z), bflo(pr.w), bfhi(pr.w)};
                    const float inv = 1.0f / (float)min(tpos0 + rr + 1, w);
                    float dv[8];
#pragma unroll
                    for (int q = 0; q < 8; ++q) { sm[q] += pv[q]; dv[q] = sm[q] * inv - pv[q]; }
                    u32x4 o; o.x = cvt_pk_bf16(dv[0], dv[1]); o.y = cvt_pk_bf16(dv[2], dv[3]); o.z = cvt_pk_bf16(dv[4], dv[5]); o.w = cvt_pk_bf16(dv[6], dv[7]);
                    *(LAS u32x4*)(sA + row * MLD + ch * 8) = o;
                    const u32x4 ps = *(const LAS u32x4*)(sP + (15 + row - w + 1) * 128 + ch * 8);
                    sm[0] -= bflo(ps.x); sm[1] -= bfhi(ps.x); sm[2] -= bflo(ps.y); sm[3] -= bfhi(ps.y); sm[4] -= bflo(ps.z); sm[5] -= bfhi(ps.z); sm[6] -= bflo(ps.w); sm[7] -= bfhi(ps.w);
                }
            } else {
                if (gi == 0) pool_sample_stage<2>(P, layer, gi, tt, sA, tid);
                else if (gi == 1) pool_sample_stage<4>(P, layer, gi, tt, sA, tid);
                else if (gi == 2) pool_sample_stage<8>(P, layer, gi, tt, sA, tid);
                else pool_sample_stage<16>(P, layer, gi, tt, sA, tid);
            }
        } else {
            const int h = j - 4;
            const bf16_t* wsb = (const bf16_t*)(P.ws + WS_WSB) + (size_t)(layer * 4 + h) * 16384;
            if (!sample) {
#pragma unroll
                for (int q_ = 0; q_ < 4; ++q_) { const int e = tid + 512 * q_; const int row = e >> 4, ch = e & 15; *(LAS u32x4*)(sA + row * MLD + ch * 8) = *(const u32x4*)(wsb + row * 128 + ch * 8); } }
            else {
#pragma unroll
                for (int q_ = 0; q_ < 4; ++q_) { const int e = tid + 512 * q_; const int i = e >> 4, ch = e & 15; u32x4 v = (u32x4){0u, 0u, 0u, 0u}; if (ch == (i >> 3)) v = *(const u32x4*)(wsb + (i & 7) * 128); *(LAS u32x4*)(sA + i * MLD + ch * 8) = v; } }
            const bf16_t* zv = ZV + 128 * h; const float* gv = P.in[I_VNG] + layer * 512 + 128 * h;
#pragma unroll
            for (int q_ = 0; q_ < 4; ++q_) {
                const int e = tid + 512 * q_;
                const int s = e >> 4, ch = e & 15, row = r0 + s;
                const u32x4 raw = *(const u32x4*)(zv + (size_t)row * 512 + ch * 8);
                const f32x4 va = *(const f32x4*)(vss + (size_t)row * 8), vb = *(const f32x4*)(vss + (size_t)row * 8 + 4);
                const float rs = rsqrtf((((va[0] + va[1]) + (va[2] + va[3])) + ((vb[0] + vb[1]) + (vb[2] + vb[3]))) * (1.0f / 512.0f) + EPS);
                const f32x4 g0 = *(const f32x4*)(gv + ch * 8), g1 = *(const f32x4*)(gv + ch * 8 + 4);
                f32x4 v0, v1;
                v0[0] = bflo(raw.x) * rs * g0[0]; v0[1] = bfhi(raw.x) * rs * g0[1]; v0[2] = bflo(raw.y) * rs * g0[2]; v0[3] = bfhi(raw.y) * rs * g0[3];
                v1[0] = bflo(raw.z) * rs * g1[0]; v1[1] = bfhi(raw.z) * rs * g1[1]; v1[2] = bflo(raw.w) * rs * g1[2]; v1[3] = bfhi(raw.w) * rs * g1[3];
#pragma unroll
                for (int jj = 0; jj < 4; ++jj) { sB[(ch * 8 + jj) * MLD + s] = f2bf(v0[jj]); sB[(ch * 8 + 4 + jj) * MLD + s] = f2bf(v1[jj]); }
                if (sample) { float* o = P.out + O_VS + ((size_t)layer * 1024 + (row - MP)) * 512 + 128 * h + ch * 8; *(f32x4*)o = v0; *(f32x4*)(o + 4) = v1; }
            }
        }
        __syncthreads();
        f32x4 acc[8];
#pragma unroll
        for (int nb = 0; nb < 8; ++nb) acc[nb] = (f32x4){0.f, 0.f, 0.f, 0.f};
        const int lr = lane & 15, kq = lane >> 4;
#pragma unroll
        for (int ks = 0; ks < 4; ++ks) {
            const bf16x8 a = *(const LAS bf16x8*)(sA + (16 * wid + lr) * MLD + ks * 32 + kq * 8);
#pragma unroll
            for (int nb = 0; nb < 8; ++nb) { const bf16x8 b = *(const LAS bf16x8*)(sB + (16 * nb + lr) * MLD + ks * 32 + kq * 8); acc[nb] = __builtin_amdgcn_mfma_f32_16x16x32_bf16(b, a, acc[nb], 0, 0, 0); }
        }
        const int row = 16 * wid + lr, grow = r0 + row;
        if (j < 4) {
#pragma unroll
            for (int nb = 0; nb < 8; ++nb) { u32x2 w; w.x = cvt_pk_bf16(acc[nb][0], acc[nb][1]); w.y = cvt_pk_bf16(acc[nb][2], acc[nb][3]); bf16_t* o = MIX + (size_t)grow * D + 128 * j + 16 * nb + 4 * kq; if (sample) st_wt64(o, w); else *(u32x2*)o = w; }
        } else {
            const int h = j - 4;
            const float bias = P.in[I_BSP][(layer * 4 + h) * 128 + (sample ? (row & 7) : row)];
#pragma unroll
            for (int nb = 0; nb < 8; ++nb) { const int col = 128 * h + 16 * nb + 4 * kq; const u32x2 uu = *(const u32x2*)(ZU + (size_t)grow * 512 + col);
                u32x2 w; w.x = cvt_pk_bf16(bflo(uu.x) * (acc[nb][0] + bias), bfhi(uu.x) * (acc[nb][1] + bias)); w.y = cvt_pk_bf16(bflo(uu.y) * (acc[nb][2] + bias), bfhi(uu.y) * (acc[nb][3] + bias));
                bf16_t* o = MIX + (size_t)grow * D + 512 + col; if (sample) st_wt64(o, w); else *(u32x2*)o = w; }
        }
        if (sample) asm volatile("s_waitcnt vmcnt(0)" ::: "memory");
        __syncthreads();
        if (sample && tid == 0) xb_add(cnt_word(P.ws, layer, 0, (tt - 128) >> 1), 1u);
    }
}

__device__ __forceinline__ void patch_panel_quarter(const Params& P, int layer, int pm, int pn) {
    const int tid = opaque_tid();
    const float* halo = (const float*)(P.ws + WS_HALO); const float* fix = (const float*)(P.ws + WS_FIX);
    const float* cw = P.in[I_CONVW] + (size_t)layer * 3 * FF; const float* cb = P.in[I_CONVB] + (size_t)layer * FF;
    bf16_t* act = (bf16_t*)(P.ws + WS_R1);
    if (tid < 352) {
        const int b = tid / 176, g4 = tid % 176, bidx = 2 * pm + b, c = 704 * pn + 4 * g4;
        if ((bidx & 15) != 0) {
            const f32x4 h2 = *(const f32x4*)(halo + ((size_t)bidx * 2 + 0) * FF + c), h1 = *(const f32x4*)(halo + ((size_t)bidx * 2 + 1) * FF + c);
            const float* f0 = fix + (((size_t)bidx * 2 + 0) * FF + c) * 2; const float* f1 = fix + (((size_t)bidx * 2 + 1) * FF + c) * 2;
            const f32x4 a0 = *(const f32x4*)f0, a1 = *(const f32x4*)(f0 + 4), b0 = *(const f32x4*)f1, b1 = *(const f32x4*)(f1 + 4);
            const f32x4 g0 = (f32x4){a0[0], a0[2], a1[0], a1[2]}, u0 = (f32x4){a0[1], a0[3], a1[1], a1[3]}, g1 = (f32x4){b0[0], b0[2], b1[0], b1[2]}, u1 = (f32x4){b0[1], b0[3], b1[1], b1[3]};
            const f32x4 w0 = *(const f32x4*)(cw + c), w1 = *(const f32x4*)(cw + FF + c), w2 = *(const f32x4*)(cw + 2 * FF + c), bb = *(const f32x4*)(cb + c);
            const f32x4 r0 = gelu4(bb + w0 * h2 + w1 * h1 + w2 * g0) * u0, r1 = gelu4(bb + w0 * h1 + w1 * g0 + w2 * g1) * u1;
            const size_t T = (size_t)128 * bidx;
            u32x2 o; o.x = cvt_pk_bf16(r0[0], r0[1]); o.y = cvt_pk_bf16(r0[2], r0[3]); st_wt64(act + T * FF + c, o);
            o.x = cvt_pk_bf16(r1[0], r1[1]); o.y = cvt_pk_bf16(r1[2], r1[3]); st_wt64(act + (T + 1) * FF + c, o);
        }
    }
    asm volatile("s_waitcnt vmcnt(0)" ::: "memory");
    __syncthreads();
    if (tid == 0) xb_add(pcnt_word(P.ws, layer, pm), 1u);
    wait_count(pcnt_word(P.ws, layer, pm), 4u, (unsigned*)(P.ws + WS_BAR) + XB_TMO);
}

__device__ __forceinline__ void final_phase(const Params& P) {
    const int tid = opaque_tid(), lane = tid & 63, wid = tid >> 6;
    const int gw = blockIdx.x * 8 + wid, NGW = gridDim.x * 8;
    const float* ssf = (const float*)(P.ws + WS_STAT);
    const f32x4* gf = (const f32x4*)P.in[I_FNG];
    const bf16_t* xb = (const bf16_t*)(P.ws + WS_XB);
    for (int row = gw; row < MT; row += NGW) {
        const float rs = rsqrtf(sum16(ssf + (size_t)row * 16) * (1.0f / 1024.0f) + EPS);
        f32x4* yr = (f32x4*)(P.out + (size_t)row * D);
        const u32x2* xr = (const u32x2*)(xb + (size_t)row * D);
#pragma unroll
        for (int j = 0; j < 4; ++j) { const u32x2 r = xr[lane + 64 * j]; const f32x4 v = (f32x4){bflo(r.x), bfhi(r.x), bflo(r.y), bfhi(r.y)}; __builtin_nontemporal_store(v * rs * gf[lane + 64 * j], yr + lane + 64 * j); }
    }
}

__global__ __launch_bounds__(512, 2) void fwd_kernel(Params P) {
    extern __shared__ __attribute__((aligned(16))) unsigned char shm[];
    LAS unsigned char* lds = (LAS unsigned char*)shm;
    cg::grid_group grid = cg::this_grid();
    volatile LAS unsigned* xst = (volatile LAS unsigned*)(lds + 131072);
    if (threadIdx.x == 0) { xst[0] = 0u; xst[1] = 0u; }
    __syncthreads();
    const XcdBarrier xb = xcd_barrier_post((unsigned*)(P.ws + WS_BAR), xst);
    phase0(P, lds);
    grid.sync();
    float* stat = (float*)(P.ws + WS_STAT);
    bf16_t* XB = (bf16_t*)(P.ws + WS_XB);
    unsigned char* R1 = P.ws + WS_R1;
#pragma unroll 1
    for (int l = 0; l < 4; ++l) {
        {
            pg8::Gemm g{XB, (const bf16_t*)(P.ws + WS_WIN) + (size_t)l * INW * D, MT, INW, D};
            pg8::StaticOrder S; S.init(MT, INW, (int)gridDim.x, (int)blockIdx.x);
            EpiA E{stat, (bf16_t*)(R1 + R1_ZP), (float*)(P.ws + WS_VSP),
                   P.out + O_POOLP + (size_t)l * 8 * 15 * 512, P.out + O_POOLS + (size_t)l * 128 * 15 * 512};
            pg8::gemm_phase(lds, g, S, E);
            if (l == 0 && blockIdx.x >= 152) convert_weights(P, lds, 0, 768, 5536, ((int)blockIdx.x - 152) * 8 + (opaque_tid() >> 6), ((int)gridDim.x - 152) * 8);
        }
        xcd_barrier(xb);
        unsigned* tmo = (unsigned*)(P.ws + WS_BAR) + XB_TMO;
        if (blockIdx.x < 16) {
            const int panel = blockIdx.x >> 2;
            wait_count(cnt_word(P.ws, l, 0, panel), 16u, tmo);
            pg8::Gemm g{(const bf16_t*)(R1 + R1_MIX), (const bf16_t*)(P.ws + WS_WOUT) + (size_t)l * D * D, MT, D, D};
            pg8::OneUnit S{64 + panel, (int)(blockIdx.x & 3)};
            { EpiX<false> E{P.in[I_XP], P.in[I_XS], XB, stat}; pg8::gemm_phase(lds, g, S, E); }
        } else mixer_phase(P, l, lds, (int)blockIdx.x - 16, (int)gridDim.x - 16);
        xcd_barrier(xb);
        {
            pg8::Gemm g{(const bf16_t*)(R1 + R1_MIX), (const bf16_t*)(P.ws + WS_WOUT) + (size_t)l * D * D, MP, D, D};
            pg8::StaticOrder S; S.init(MP, D, (int)gridDim.x, (int)blockIdx.x);
            { EpiX<false> E{P.in[I_XP], P.in[I_XS], XB, stat}; pg8::gemm_phase(lds, g, S, E); }
        }
        xcd_barrier(xb);
        {
            pg8::Gemm g{XB, (const bf16_t*)(P.ws + WS_WGU) + (size_t)l * NGU * D, MT, NGU, D};
            pg8::COrder S; S.so.init(MP, NGU, 256, 0); S.c = (int)blockIdx.x; S.seg = 0;
            EpiC E{stat, P.in[I_CONVW] + (size_t)l * 3 * FF, P.in[I_CONVB] + (size_t)l * FF, P.in[I_SCONV] + (size_t)l * 128 * 2 * FF,
                   (bf16_t*)R1, (float*)(P.ws + WS_HALO), (float*)(P.ws + WS_FIX), P.out + O_CONVP + (size_t)l * 8 * 2 * FF, P.out + O_CONVS + (size_t)l * 128 * 2 * FF, cnt_word(P.ws, l, 1, 0)};
            pg8::gemm_phase(lds, g, S, E);
            if (l < 3 && blockIdx.x < 240) convert_weights(P, lds, l + 1, 0, 5536, (int)blockIdx.x * 8 + (opaque_tid() >> 6), 240 * 8);
            if (blockIdx.x >= 240) {
                const int su = (int)blockIdx.x - 240, panel = su >> 2;
                wait_count(cnt_word(P.ws, l, 1, panel), 176u, tmo);
                pg8::Gemm gd{(const bf16_t*)R1, (const bf16_t*)(P.ws + WS_WDN) + (size_t)l * D * FF, MT, D, FF};
                pg8::OneUnit Sd{64 + panel, su & 3};
                EpiX<false> Ed{P.in[I_XP], P.in[I_XS], XB, stat};
                pg8::gemm_phase(lds, gd, Sd, Ed);
                S.seg = 1;
                pg8::gemm_phase(lds, g, S, E);
            }
        }
        xcd_barrier(xb);
        {
            pg8::Gemm g{(const bf16_t*)R1, (const bf16_t*)(P.ws + WS_WDN) + (size_t)l * D * FF, MP, D, FF};
            pg8::StaticOrder S; S.init(MP, D, (int)gridDim.x, (int)blockIdx.x);
            { pg8::Unit u0; if (S.next(0, u0)) patch_panel_quarter(P, l, u0.pm, u0.pn); }
            EpiX<false> E{P.in[I_XP], P.in[I_XS], XB, stat};
            pg8::gemm_phase(lds, g, S, E);
        }
        xcd_barrier(xb);
    }
    final_phase(P);
}

extern "C" void kernel_launch(void* const* d_in, const int* in_sizes, int n_in, void* d_out, int out_size, void* d_ws, size_t ws_size, hipStream_t stream) {
    static int grid_blocks = 0;
    if (grid_blocks == 0) {
        if (n_in != 19 || ws_size < WS_END) { fprintf(stderr, "kernel_launch: unexpected n_in %d or ws_size %zu (< %zu)\n", n_in, ws_size, (size_t)WS_END); grid_blocks = -1; return; }
        int dev = 0, cus = 0, per_cu = 0;
        hipGetDevice(&dev);
        hipDeviceGetAttribute(&cus, hipDeviceAttributeMultiprocessorCount, dev);
        if (hipFuncSetAttribute((const void*)fwd_kernel, hipFuncAttributeMaxDynamicSharedMemorySize, LDS_BYTES) != hipSuccess) { fprintf(stderr, "kernel_launch: hipFuncSetAttribute failed\n"); grid_blocks = -1; return; }
        hipOccupancyMaxActiveBlocksPerMultiprocessor(&per_cu, (const void*)fwd_kernel, 512, LDS_BYTES);
        if (per_cu < 1) { fprintf(stderr, "kernel_launch: occupancy query says %d blocks per CU\n", per_cu); per_cu = 1; }
        (void)hipGetLastError();
        grid_blocks = cus * per_cu;
        if (grid_blocks != 256) { fprintf(stderr, "kernel_launch: this build schedules for exactly 256 workgroups, got %d\n", grid_blocks); grid_blocks = 256; }
    }
    if (grid_blocks < 0) return;
    if (hipMemsetAsync((char*)d_ws + WS_BAR, 0, (XCD_BAR_WORDS + N_CNT * 64) * 4, stream) != hipSuccess) { fprintf(stderr, "kernel_launch: memset of barrier words failed\n"); return; }
    Params p{};
    for (int i = 0; i < 19; ++i) p.in[i] = (const float*)d_in[i];
    p.out = (float*)d_out; p.ws = (unsigned char*)d_ws;
    void* args[] = {&p};
    hipError_t e = hipLaunchCooperativeKernel((const void*)fwd_kernel, dim3(grid_blocks), dim3(512), args, LDS_BYTES, stream);
    if (e != hipSuccess) fprintf(stderr, "cooperative launch failed: %s (grid %d)\n", hipGetErrorString(e), grid_blocks);
}
```

```cpp
#include <hip/hip_runtime.h>
#include <hip/hip_cooperative_groups.h>
#include <cstdio>
namespace cg = cooperative_groups;

#define LAS __attribute__((address_space(3)))
typedef unsigned short bf16_t;
typedef short bf16x8 __attribute__((ext_vector_type(8)));
typedef float f32x4 __attribute__((ext_vector_type(4)));
typedef unsigned u32x4 __attribute__((ext_vector_type(4)));
typedef unsigned u32x2 __attribute__((ext_vector_type(2)));

constexpr int D = 1024, MP = 16384, MT = 17408, INW = 1536, FF = 2816, NGU = 5632;
constexpr float EPS = 1e-6f;

constexpr size_t O_POOLP = 17825792, O_POOLS = 18071552, O_CONVP = 22003712, O_CONVS = 22183936, O_VS = 25067520;
constexpr size_t WS_WIN = 0, WS_WOUT = 12582912, WS_WGU = 20971520, WS_WDN = 67108864, WS_PWT = 90177536, WS_WSB = 90701824,
                 WS_XB = 91226112, WS_R1 = 126877696, WS_HALO = 224919552, WS_FIX = 228005888, WS_STAT = 234178560, WS_VSP = 235292672, WS_BAR = 235849728, WS_END = 235937280;
constexpr size_t R1_ZP = 0, R1_ZU = 17825792, R1_ZV = 35651584, R1_MIX = 53477376;
constexpr int LDS_BYTES = 131072 + 16;

struct Params {
    const float* in[19];
    float* out;
    unsigned char* ws;
};
enum { I_XP = 0, I_XS, I_SPOOL, I_SCONV, I_N1G, I_WIN, I_POOLW, I_PSCALE, I_VNG, I_WSP, I_BSP, I_WOUT, I_N2G, I_WGATE, I_WUP, I_CONVW, I_CONVB, I_WDOWN, I_FNG };

__device__ __forceinline__ unsigned cvt_pk_bf16(float lo, float hi) { unsigned r; asm("v_cvt_pk_bf16_f32 %0, %1, %2" : "=v"(r) : "v"(lo), "v"(hi)); return r; }
__device__ __forceinline__ bf16_t f2bf(float f) { return (bf16_t)(cvt_pk_bf16(f, 0.f) & 0xffffu); }
__device__ __forceinline__ float bf2f(bf16_t b) { return __uint_as_float(((unsigned)b) << 16); }
__device__ __forceinline__ float bflo(unsigned w) { return __uint_as_float(w << 16); }
__device__ __forceinline__ float bfhi(unsigned w) { return __uint_as_float(w & 0xffff0000u); }
__device__ __forceinline__ float gelu_f(float v) {
    const float av = fabsf(v), d = av * 0.2316418882f + 1.0f;
    const float t = __builtin_amdgcn_rcpf(d);
    float q = t * 0.5307027145f + (-0.7265760135f); q = q * t + 0.7107068705f; q = q * t + (-0.142248368f); q = q * t + 0.127414796f; q = q * t;
    const float e = __builtin_amdgcn_exp2f(v * v * (-0.72134752044f));
    const float m = v * (q * e);
    return v < 0.f ? m : v - m;
}
typedef float f32x2 __attribute__((ext_vector_type(2)));
__device__ __forceinline__ f32x2 gelu_pk(f32x2 v) {
    const f32x2 av = __builtin_elementwise_abs(v), d = av * 0.2316418882f + 1.0f;
    f32x2 t; t.x = __builtin_amdgcn_rcpf(d.x); t.y = __builtin_amdgcn_rcpf(d.y);
    f32x2 q = t * 0.5307027145f + (-0.7265760135f); q = q * t + 0.7107068705f; q = q * t + (-0.142248368f); q = q * t + 0.127414796f; q = q * t;
    const f32x2 u = v * 0.8493218003f, s = -(u * u);
    f32x2 e; e.x = __builtin_amdgcn_exp2f(s.x); e.y = __builtin_amdgcn_exp2f(s.y);
    const f32x2 h = 0.5f - q * e;
    return v * 0.5f + av * h;
}
__device__ __forceinline__ f32x4 gelu4(f32x4 v) { const f32x2 a = gelu_pk((f32x2){v[0], v[1]}), b = gelu_pk((f32x2){v[2], v[3]}); return (f32x4){a.x, a.y, b.x, b.y}; }
__device__ __forceinline__ float sum16(const float* p) { const f32x4 a = *(const f32x4*)p, b = *(const f32x4*)(p + 4), c = *(const f32x4*)(p + 8), d = *(const f32x4*)(p + 12); const f32x4 s = (a + b) + (c + d); return (s[0] + s[1]) + (s[2] + s[3]); }
__device__ __forceinline__ float wave_sum(float v) {
#pragma unroll
    for (int o = 1; o < 64; o <<= 1) v += __shfl_xor(v, o);
    return v;
}

__device__ __forceinline__ int opaque_tid() { int t = threadIdx.x; asm volatile("" : "+v"(t)); return t; }

#define XB_TMO      128
#define XB_XCNT(j)  (256  + 64 * (j))
#define XB_XSUB(j)  (1280 + 64 * (j))
#define XB_XGEN(j)  (2304 + 64 * (j))
#define XB_TOP      3328
#define XB_TOPGEN   3392
#define XCD_BAR_WORDS 3456
#define XB_SPIN_CAP (1u << 22)
__device__ __forceinline__ unsigned xb_ld(unsigned* p)              { return __hip_atomic_load(p, __ATOMIC_RELAXED, __HIP_MEMORY_SCOPE_AGENT); }
__device__ __forceinline__ unsigned xb_add(unsigned* p, unsigned v) { return __hip_atomic_fetch_add(p, v, __ATOMIC_RELAXED, __HIP_MEMORY_SCOPE_AGENT); }
__device__ __forceinline__ unsigned xb_xcc_id() { return (unsigned)__builtin_amdgcn_s_getreg((3 << 11) | 20) & 0xFu; }
#define XB_SPIN(cond, bar) do { unsigned _sp = 0; while (cond) { __builtin_amdgcn_s_sleep(1); \
    if ((++_sp & 255u) == 0u) { if (xb_ld(&(bar)[XB_TMO])) break; if (_sp > XB_SPIN_CAP) { atomicAdd(&(bar)[XB_TMO], 1u); break; } } } } while (0)
struct XcdBarrier { unsigned* bar; unsigned x; volatile LAS unsigned* st; };
__device__ __forceinline__ XcdBarrier xcd_barrier_post(unsigned* bar, volatile LAS unsigned* st) {
    XcdBarrier b; b.bar = bar; b.x = xb_xcc_id(); b.st = st;
    if (threadIdx.x == 0) (void)xb_add(&bar[XB_XCNT(b.x)], 1u);
    return b;
}
__device__ __forceinline__ void xcd_barrier_complete(unsigned* bar, unsigned x, unsigned& nloc, unsigned& nx) {
    const unsigned G = gridDim.x * gridDim.y * gridDim.z;
    unsigned sum, cnt, mine, sp = 0u;
    for (;;) {
        sum = 0u; cnt = 0u; mine = 0u;
#pragma unroll
        for (unsigned j = 0; j < 16; ++j) { const unsigned c = xb_ld(&bar[XB_XCNT(j)]); sum += c; cnt += (c > 0u) ? 1u : 0u; mine = (j == x) ? c : mine; }
        if (sum == G) break;
        __builtin_amdgcn_s_sleep(1);
        if ((++sp & 255u) == 0u) { if (xb_ld(&bar[XB_TMO])) break; if (sp > XB_SPIN_CAP) { atomicAdd(&bar[XB_TMO], 1u); break; } }
    }
    nloc = mine > 0u ? mine : 1u; nx = cnt > 0u ? cnt : 1u;
}
__device__ __forceinline__ void xcd_barrier(const XcdBarrier& b) {
    asm volatile("s_waitcnt vmcnt(0)" ::: "memory");
    __syncthreads();
    if (threadIdx.x == 0) {
        unsigned* bar = b.bar;
        __builtin_amdgcn_s_waitcnt(0);
        unsigned nloc = b.st[0], nx = b.st[1];
        if (nloc == 0u) { xcd_barrier_complete(bar, b.x, nloc, nx); b.st[0] = nloc; b.st[1] = nx; }
        const unsigned old = xb_add(&bar[XB_XSUB(b.x)], 1u);
        const unsigned gen = old / nloc;
        if (old + 1u == (gen + 1u) * nloc) {
            __builtin_amdgcn_fence(__ATOMIC_RELEASE, "agent");
            asm volatile("s_waitcnt vmcnt(0)" ::: "memory");
            const unsigned og = xb_add(&bar[XB_TOP], 1u);
            const unsigned tg = og / nx;
            if (og + 1u == (tg + 1u) * nx) xb_add(&bar[XB_TOPGEN], 1u);
            else XB_SPIN(xb_ld(&bar[XB_TOPGEN]) == tg, bar);
            __builtin_amdgcn_fence(__ATOMIC_ACQUIRE, "agent");
            xb_add(&bar[XB_XGEN(b.x)], 1u);
            asm volatile("s_waitcnt vmcnt(0)" ::: "memory");
        } else {
            XB_SPIN(xb_ld(&bar[XB_XGEN(b.x)]) == gen, bar);
            __builtin_amdgcn_fence(__ATOMIC_ACQUIRE, "agent");
            asm volatile("s_waitcnt vmcnt(0)" ::: "memory");
        }
    }
    __syncthreads();
}

constexpr int N_CNT = 32 + 256;
__device__ __forceinline__ unsigned* cnt_word(unsigned char* ws, int layer, int kind, int panel) { return (unsigned*)(ws + WS_BAR) + XCD_BAR_WORDS + ((layer * 2 + kind) * 4 + panel) * 64; }
__device__ __forceinline__ unsigned* pcnt_word(unsigned char* ws, int layer, int pm) { return (unsigned*)(ws + WS_BAR) + XCD_BAR_WORDS + (32 + layer * 64 + pm) * 64; }
__device__ __forceinline__ void st_wt64(void* p, u32x2 w) { __hip_atomic_store((unsigned long long*)p, (unsigned long long)w.x | ((unsigned long long)w.y << 32), __ATOMIC_RELAXED, __HIP_MEMORY_SCOPE_AGENT); }
__device__ __forceinline__ void wait_count(unsigned* word, unsigned need, unsigned* tmo) {
    if (threadIdx.x == 0) {
        unsigned sp = 0;
        while (xb_ld(word) < need) { __builtin_amdgcn_s_sleep(2); if ((++sp & 255u) == 0u) { if (xb_ld(tmo)) break; if (sp > XB_SPIN_CAP) { atomicAdd(tmo, 1u); break; } } }
        __builtin_amdgcn_fence(__ATOMIC_ACQUIRE, "agent");
        asm volatile("s_waitcnt vmcnt(0)" ::: "memory");
    }
    __syncthreads();
}

namespace pg8 {
constexpr int BM = 256, BK = 64, HALF = 128, HTB = HALF * BK * 2, NXCD = 8, WGM = 8;
__device__ __forceinline__ int lds_byte(int r, int c) { const int st = (r >> 4) * 2 + (c >> 5), rr = r & 15, cc = c & 31, ob = rr * 64 + cc * 2; return st * 1024 + (ob ^ (((ob >> 9) & 1) << 5)); }
__device__ __forceinline__ void stage_rc(int b, int& R, int& C) { const int st = b / 1024, sb = b % 1024, swz = sb ^ (((sb >> 9) & 1) << 5); R = (st >> 1) * 16 + swz / 64; C = (st & 1) * 32 + (swz % 64) / 2; }
__device__ __forceinline__ int perm32(int rho) { const int n = rho >> 4, i = rho & 15; return 8 * (i >> 2) + 4 * n + (i & 3); }
struct Unit { int pm, pn; };
struct Gemm { const bf16_t* A; const bf16_t* Bt; int M, N, K; };
struct StaticOrder {
    int nM, nN, nwg, G, c;
    __device__ __forceinline__ void init(int M, int N, int G_, int c_) { nM = M / BM; nN = N / BM; nwg = nM * nN; G = G_; c = c_; }
    __device__ __forceinline__ void map(int L, Unit& u) const {
        int wgid = L; { const int q = nwg / NXCD, r = nwg % NXCD, xcd = wgid % NXCD, off = wgid / NXCD; wgid = (xcd < r ? xcd * (q + 1) : r * (q + 1) + (xcd - r) * q) + off; }
        const int nig = WGM * nN, gid = wgid / nig, fm = gid * WGM, gsz = (nM - fm) < WGM ? (nM - fm) : WGM;
        u.pm = fm + ((wgid % nig) % gsz); u.pn = (wgid % nig) / gsz;
    }
    __device__ __forceinline__ bool next(int i, Unit& u) const { const long L = (long)i * G + c; if (L >= nwg) return false; map((int)L, u); return true; }
};
struct OneUnit { int pm, pn; __device__ __forceinline__ bool next(int i, Unit& u) const { if (i) return false; u.pm = pm; u.pn = pn; return true; } };
struct COrder {
    StaticOrder so; int c, seg;
    __device__ __forceinline__ bool next(int i, Unit& u) const {
        if (c < 128) { if (i > 5) return false; so.map(i * 256 + c, u); return true; }
        if (c < 216) { if (i > 5) return false; if (i == 0) { const int su = c - 128; u.pm = 64 + su / 22; u.pn = su % 22; return true; } so.map((i - 1) * 256 + c, u); return true; }
        if (c < 232) { if (i > 5) return false; so.map(i < 5 ? i * 256 + c : 1024 + 240 + (c - 216), u); return true; }
        if (c < 240) { if (i > 4) return false; so.map(i * 256 + c, u); return true; }
        if (seg == 0) { if (i > 0) return false; so.map(c, u); return true; }
        if (i > 2) return false; so.map((i + 1) * 256 + c, u); return true;
    }
};

template <class Epi, class Sched>
__device__ __forceinline__ void gemm_phase(LAS unsigned char* lds, const Gemm g, const Sched& S, const Epi& E) {
    const int tid = opaque_tid(), wid = __builtin_amdgcn_readfirstlane(tid >> 6), lane = tid & 63, wr = wid >> 2, wc = wid & 3, fr = lane & 15, fq = lane >> 4;
    const int K = g.K, nt = K / BK;
    unsigned voffA[2], voffB[2];
#pragma unroll
    for (int i = 0; i < 2; ++i) { int R, C; stage_rc(tid * 16 + i * 8192, R, C); const int Rb = (R & ~31) + perm32(R & 31);
        const int Ra = Epi::AROWPERM ? (8 * (16 * (R >> 6) + (R & 15)) + ((R >> 4) & 3)) : R;
        voffA[i] = (unsigned)(Ra * K + C) * 2u; voffB[i] = (unsigned)(Rb * K + C) * 2u; }
    const size_t kstep = (size_t)(BK * 2);
    const size_t hstepB = (size_t)HALF * K * 2;
    const size_t hstepA = Epi::AROWPERM ? (size_t)4 * K * 2 : hstepB;
    const size_t tstep = 2 * hstepB;
    const unsigned ldsw = (unsigned)wid * 1024u;
    const int aoff = lds_byte(wr * 64 + fr, fq * 8), boff = lds_byte(wc * 32 + fr, fq * 8);
#define PG8_SA(b, h) (((b) * 2 + (h)) * HTB)
#define PG8_SB(b, h) ((4 + (b) * 2 + (h)) * HTB)
#define PG8_STAGE(bufoff, gbase, voff) do { _Pragma("unroll") for (int _i = 0; _i < 2; ++_i) \
        __builtin_amdgcn_global_load_lds((const unsigned*)((const char*)(gbase) + (voff)[_i]), (LAS unsigned*)(lds + (bufoff) + ldsw + _i * 8192), 16, 0, 0); } while (0)
#define PG8_LDA(dst, b, h) do { _Pragma("unroll") for (int m = 0; m < 4; ++m) _Pragma("unroll") for (int k = 0; k < 2; ++k) dst[m][k] = *(const LAS bf16x8*)(lds + PG8_SA(b, h) + aoff + m * 2048 + k * 1024); } while (0)
#define PG8_LDB(dst, b, h) do { _Pragma("unroll") for (int n = 0; n < 2; ++n) _Pragma("unroll") for (int k = 0; k < 2; ++k) dst[n][k] = *(const LAS bf16x8*)(lds + PG8_SB(b, h) + boff + n * 2048 + k * 1024); } while (0)
#define PG8_MMA(ai, bj, At, Bt) do { __builtin_amdgcn_s_setprio(1); _Pragma("unroll") for (int m = 0; m < 4; ++m) _Pragma("unroll") for (int n = 0; n < 2; ++n) _Pragma("unroll") for (int k = 0; k < 2; ++k) \
        acc[ai][bj][m][n] = __builtin_amdgcn_mfma_f32_16x16x32_bf16(Bt[n][k], At[m][k], acc[ai][bj][m][n], 0, 0, 0); __builtin_amdgcn_s_setprio(0); } while (0)
#define PG8_WAIT_V(n) asm volatile("s_waitcnt vmcnt(" #n ")" ::: "memory")
#define PG8_WAIT_L(n) asm volatile("s_waitcnt lgkmcnt(" #n ")" ::: "memory")
#define PG8_BAR __builtin_amdgcn_s_barrier()
#define PG8_SCHED __builtin_amdgcn_sched_barrier(0)
    Unit cur, nxt; int ui = 0;
    if (!S.next(0, cur)) return;
    f32x4 acc[2][2][4][2];
    typename Epi::Raw raw;
    if constexpr (Epi::HAS_INIT) E.load_init(raw, cur, wr, wc);
    bf16x8 At[4][2], B0[2][2], B1[2][2];
    const char* cA = (const char*)g.A + (size_t)cur.pm * tstep; const char* cB = (const char*)g.Bt + (size_t)cur.pn * tstep;
    PG8_STAGE(PG8_SB(0, 0), cB, voffB); PG8_STAGE(PG8_SA(0, 0), cA, voffA); PG8_STAGE(PG8_SB(0, 1), cB + hstepB, voffB); PG8_STAGE(PG8_SA(0, 1), cA + hstepA, voffA);
    if (wr == 1) PG8_BAR;
    PG8_WAIT_V(4); PG8_BAR;
    PG8_STAGE(PG8_SB(1, 0), cB + kstep, voffB); PG8_STAGE(PG8_SA(1, 0), cA + kstep, voffA); PG8_STAGE(PG8_SB(1, 1), cB + hstepB + kstep, voffB);
    PG8_WAIT_V(6); PG8_BAR;
    if constexpr (Epi::HAS_INIT) E.apply_init(acc, raw);
    else {
#pragma unroll
        for (int a = 0; a < 2; ++a)
#pragma unroll
            for (int b = 0; b < 2; ++b)
#pragma unroll
                for (int m = 0; m < 4; ++m)
#pragma unroll
                    for (int n = 0; n < 2; ++n) acc[a][b][m][n] = (f32x4){0.f, 0.f, 0.f, 0.f};
    }
    for (;;) {
        const bool has_next = S.next(ui + 1, nxt);
        const char* nA = has_next ? (const char*)g.A + (size_t)nxt.pm * tstep : cA; const char* nB = has_next ? (const char*)g.Bt + (size_t)nxt.pn * tstep : cB;
        for (int t = 0; t < nt; t += 2) {
            const bool last = (t == nt - 2);
            const char* a1 = cA + (size_t)(t + 1) * kstep;
            const char* a2 = last ? nA : cA + (size_t)(t + 2) * kstep; const char* b2 = last ? nB : cB + (size_t)(t + 2) * kstep;
            const char* a3 = a2 + kstep; const char* b3 = b2 + kstep;
            PG8_LDB(B0, 0, 0); PG8_SCHED; PG8_LDA(At, 0, 0); PG8_STAGE(PG8_SA(1, 1), a1 + hstepA, voffA);
            PG8_WAIT_L(8); PG8_BAR; PG8_WAIT_L(0); PG8_MMA(0, 0, At, B0); PG8_BAR; PG8_SCHED;
            PG8_LDB(B1, 0, 1); PG8_STAGE(PG8_SB(0, 0), b2, voffB);
            PG8_BAR; PG8_WAIT_L(0); PG8_MMA(0, 1, At, B1); PG8_BAR;
            PG8_LDA(At, 0, 1); PG8_STAGE(PG8_SA(0, 0), a2, voffA);
            PG8_BAR; PG8_WAIT_L(0); PG8_MMA(1, 0, At, B0); PG8_BAR; PG8_SCHED;
            PG8_STAGE(PG8_SB(0, 1), b2 + hstepB, voffB);
            PG8_WAIT_V(6); PG8_BAR; PG8_MMA(1, 1, At, B1); PG8_BAR;
            PG8_LDB(B0, 1, 0); PG8_SCHED; PG8_LDA(At, 1, 0); PG8_STAGE(PG8_SA(0, 1), a2 + hstepA, voffA);
            PG8_WAIT_L(8); PG8_BAR; PG8_WAIT_L(0); PG8_MMA(0, 0, At, B0); PG8_BAR; PG8_SCHED;
            PG8_LDB(B1, 1, 1); PG8_STAGE(PG8_SB(1, 0), b3, voffB);
            PG8_BAR; PG8_WAIT_L(0); PG8_MMA(0, 1, At, B1); PG8_BAR;
            PG8_LDA(At, 1, 1); PG8_STAGE(PG8_SA(1, 0), a3, voffA);
            PG8_BAR; PG8_WAIT_L(0); PG8_MMA(1, 0, At, B0); PG8_BAR; PG8_SCHED;
            PG8_STAGE(PG8_SB(1, 1), b3 + hstepB, voffB);
            PG8_WAIT_V(6); PG8_BAR; PG8_MMA(1, 1, At, B1); PG8_BAR;
        }
        E(acc, cur, wr, wc, fr, fq);
        if (!has_next) break;
        if constexpr (Epi::HAS_INIT) { E.load_init(raw, nxt, wr, wc); E.apply_init(acc, raw); }
        else {
#pragma unroll
            for (int a = 0; a < 2; ++a)
#pragma unroll
                for (int b = 0; b < 2; ++b)
#pragma unroll
                    for (int m = 0; m < 4; ++m)
#pragma unroll
                        for (int n = 0; n < 2; ++n) acc[a][b][m][n] = (f32x4){0.f, 0.f, 0.f, 0.f};
        }
        cur = nxt; cA = nA; cB = nB; ++ui;
    }
    PG8_WAIT_V(0);
    if (wr == 0) PG8_BAR;
    PG8_BAR;
#undef PG8_SA
#undef PG8_SB
#undef PG8_STAGE
#undef PG8_LDA
#undef PG8_LDB
#undef PG8_MMA
#undef PG8_WAIT_V
#undef PG8_WAIT_L
#undef PG8_BAR
#undef PG8_SCHED
}
}

struct NoRaw {};
struct EpiA {
    static constexpr bool AROWPERM = false, HAS_INIT = false; typedef NoRaw Raw;
    const float* ss1; bf16_t* zp; float* vss; float* poolP; float* poolS;
    __device__ __forceinline__ void operator()(const f32x4 (&acc)[2][2][4][2], const pg8::Unit& u, int wr, int wc, int fr_, int fq_) const {
        const int lane_ = opaque_tid() & 63, fr = lane_ & 15, fq = lane_ >> 4;
        const int row0 = u.pm * 256 + wr * 64 + fr;
        const int kind = u.pn >> 1;
        const int colt = (u.pn & 1) * 256 + wc * 32 + 8 * fq;
        bf16_t* base = zp + (size_t)kind * ((size_t)MT * 512);
        float my0, my1;
        { const int k0 = 2 * fq, k1 = k0 + 1;
          my0 = rsqrtf(sum16(ss1 + (size_t)(row0 + 128 * (k0 >> 2) + 16 * (k0 & 3)) * 16) * (1.0f / 1024.0f) + EPS);
          my1 = rsqrtf(sum16(ss1 + (size_t)(row0 + 128 * (k1 >> 2) + 16 * (k1 & 3)) * 16) * (1.0f / 1024.0f) + EPS); }
        float rsv[8];
#pragma unroll
        for (int k = 0; k < 8; ++k) rsv[k] = __shfl((k & 1) ? my1 : my0, (k >> 1) * 16 + fr);
#pragma unroll
        for (int ai = 0; ai < 2; ++ai)
#pragma unroll
            for (int m = 0; m < 4; ++m) {
                const int row = row0 + ai * 128 + m * 16;
                const float rs = rsv[ai * 4 + m];
                float ssum = 0.f;
#pragma unroll
                for (int bj = 0; bj < 2; ++bj) {
                    f32x4 v0 = acc[ai][bj][m][0] * rs, v1 = acc[ai][bj][m][1] * rs;
                    const int col = colt + bj * 128;
                    if (kind == 0) {
                        if (row < MP) { const int t = row & 2047; if (t >= 2033) { float* o = poolP + ((size_t)(row >> 11) * 15 + (t - 2033)) * 512 + col; *(f32x4*)o = v0; *(f32x4*)(o + 4) = v1; } }
                        else { const int rr = row - MP; float* o = poolS + ((size_t)(rr >> 3) * 15 + 7 + (rr & 7)) * 512 + col; *(f32x4*)o = v0; *(f32x4*)(o + 4) = v1; }
                    } else {
                        v0 = gelu4(v0); v1 = gelu4(v1);
                        if (kind == 2) ssum += (v0[0] * v0[0] + v0[1] * v0[1]) + (v0[2] * v0[2] + v0[3] * v0[3]) + (v1[0] * v1[0] + v1[1] * v1[1]) + (v1[2] * v1[2] + v1[3] * v1[3]);
                    }
                    u32x4 w; w.x = cvt_pk_bf16(v0[0], v0[1]); w.y = cvt_pk_bf16(v0[2], v0[3]); w.z = cvt_pk_bf16(v1[0], v1[1]); w.w = cvt_pk_bf16(v1[2], v1[3]);
                    *(u32x4*)(base + (size_t)row * 512 + col) = w;
                }
                if (kind == 2) { ssum += __shfl_xor(ssum, 16); ssum += __shfl_xor(ssum, 32); if (fq == 0) vss[(size_t)row * 8 + (u.pn & 1) * 4 + wc] = ssum; }
            }
    }
};
template <bool FROM_IN> struct EpiX {
    static constexpr bool AROWPERM = false, HAS_INIT = !FROM_IN;
    struct Raw { u32x4 r[2][4][2]; };
    const float* xin_p; const float* xin_s; bf16_t* xb; float* ssout;
    __device__ __forceinline__ void load_init(Raw& raw, const pg8::Unit& u, int wr, int wc) const {
        const int lane_ = opaque_tid() & 63, fr = lane_ & 15, fq = lane_ >> 4;
        const bf16_t* p = xb + (size_t)(u.pm * 256 + wr * 64 + fr) * D + u.pn * 256 + wc * 32 + 8 * fq;
#pragma unroll
        for (int ai = 0; ai < 2; ++ai)
#pragma unroll
            for (int m = 0; m < 4; ++m)
#pragma unroll
                for (int bj = 0; bj < 2; ++bj) raw.r[ai][m][bj] = *(const u32x4*)(p + (size_t)(ai * 128 + m * 16) * D + bj * 128);
    }
    __device__ __forceinline__ void apply_init(f32x4 (&acc)[2][2][4][2], const Raw& raw) const {
#pragma unroll
        for (int ai = 0; ai < 2; ++ai)
#pragma unroll
            for (int m = 0; m < 4; ++m)
#pragma unroll
                for (int bj = 0; bj < 2; ++bj) {
                    const u32x4 r = raw.r[ai][m][bj]; acc[ai][bj][m][0] = (f32x4){bflo(r.x), bfhi(r.x), bflo(r.y), bfhi(r.y)}; acc[ai][bj][m][1] = (f32x4){bflo(r.z), bfhi(r.z), bflo(r.w), bfhi(r.w)};
                }
    }
    __device__ __forceinline__ void operator()(const f32x4 (&acc)[2][2][4][2], const pg8::Unit& u, int wr, int wc, int fr_, int fq_) const {
        const int lane_ = opaque_tid() & 63, fr = lane_ & 15, fq = lane_ >> 4;
        const int row0 = u.pm * 256 + wr * 64 + fr, col0 = u.pn * 256 + wc * 32 + 8 * fq;
#pragma unroll
        for (int ai = 0; ai < 2; ++ai)
#pragma unroll
            for (int m = 0; m < 4; ++m) {
                const int row = row0 + ai * 128 + m * 16;
                float ssum = 0.f;
#pragma unroll
                for (int bj = 0; bj < 2; ++bj) {
                    const int col = col0 + bj * 128;
                    f32x4 v0 = acc[ai][bj][m][0], v1 = acc[ai][bj][m][1];
                    if constexpr (FROM_IN) { const float* xo = row < MP ? xin_p + (size_t)row * D : xin_s + (size_t)(row - MP) * D; v0 += *(const f32x4*)(xo + col); v1 += *(const f32x4*)(xo + col + 4); }
                    ssum += (v0[0] * v0[0] + v0[1] * v0[1]) + (v0[2] * v0[2] + v0[3] * v0[3]) + (v1[0] * v1[0] + v1[1] * v1[1]) + (v1[2] * v1[2] + v1[3] * v1[3]);
                    u32x4 w; w.x = cvt_pk_bf16(v0[0], v0[1]); w.y = cvt_pk_bf16(v0[2], v0[3]); w.z = cvt_pk_bf16(v1[0], v1[1]); w.w = cvt_pk_bf16(v1[2], v1[3]);
                    *(u32x4*)(xb + (size_t)row * D + col) = w;
                }
                ssum += __shfl_xor(ssum, 16); ssum += __shfl_xor(ssum, 32); if (fq == 0) ssout[(size_t)row * 16 + u.pn * 4 + wc] = ssum;
            }
    }
};
struct EpiC {
    static constexpr bool AROWPERM = true, HAS_INIT = false; typedef NoRaw Raw;
    const float* ss2; const float* cw; const float* cb; const float* sconv; bf16_t* act; float* halo; float* fix; float* convP; float* convS; unsigned* actcnt;
    __device__ __forceinline__ void operator()(const f32x4 (&acc)[2][2][4][2], const pg8::Unit& u, int wr, int wc, int fr_, int fq_) const {
        const int lane_ = opaque_tid() & 63, fr = lane_ & 15, fq = lane_ >> 4;
        const int q = 16 * wr + fr;
        const int tok0 = u.pm * 256 + 8 * q;
        const bool sample = (u.pm * 256) >= MP;
        const float my0 = rsqrtf(sum16(ss2 + (size_t)(tok0 + 2 * fq) * 16) * (1.0f / 1024.0f) + EPS), my1 = rsqrtf(sum16(ss2 + (size_t)(tok0 + 2 * fq + 1) * 16) * (1.0f / 1024.0f) + EPS);
        float rs[8];
#pragma unroll
        for (int k = 0; k < 8; ++k) rs[k] = __shfl((k & 1) ? my1 : my0, (k >> 1) * 16 + fr);
        const int cgl = u.pn * 128 + wc * 32 + 8 * fq;
        const bool first = (fr == 0), lastl = (fr == 15);
        const int bidx = 2 * u.pm + wr;
        const bool seqstart = (bidx & 15) == 0;
        const bool deferred = !sample && first && !seqstart;
        const int sb = sample ? ((tok0 - MP) >> 3) : 0;
#pragma unroll
        for (int n = 0; n < 2; ++n) {
            const int c = cgl + 4 * n;
            const f32x4 w0 = *(const f32x4*)(cw + c), w1 = *(const f32x4*)(cw + FF + c), w2 = *(const f32x4*)(cw + 2 * FF + c), bb = *(const f32x4*)(cb + c);
            const f32x4 g6 = acc[1][0][2][n] * rs[6], g7 = acc[1][0][3][n] * rs[7];
            f32x4 gm1, gm2;
            if (sample) { gm2 = *(const f32x4*)(sconv + ((size_t)sb * 2 + 0) * FF + c); gm1 = *(const f32x4*)(sconv + ((size_t)sb * 2 + 1) * FF + c); }
            else {
#pragma unroll
                for (int j = 0; j < 4; ++j) { gm1[j] = __shfl_up(g7[j], 1, 16); gm2[j] = __shfl_up(g6[j], 1, 16); }
                if (first) { gm1 = (f32x4){0.f, 0.f, 0.f, 0.f}; gm2 = gm1; }
            }
#pragma unroll
            for (int k = 0; k < 8; ++k) {
                const f32x4 gk = acc[k >> 2][0][k & 3][n] * rs[k], uk = acc[k >> 2][1][k & 3][n] * rs[k];
                const f32x4 cv = bb + w0 * gm2 + w1 * gm1 + w2 * gk;
                const f32x4 a = gelu4(cv) * uk;
                if (!(deferred && k < 2)) { u32x2 w; w.x = cvt_pk_bf16(a[0], a[1]); w.y = cvt_pk_bf16(a[2], a[3]); if (sample) st_wt64(act + (size_t)(tok0 + k) * FF + c, w); else *(u32x2*)(act + (size_t)(tok0 + k) * FF + c) = w; }
                if (k < 2 && deferred) { float* o = fix + (((size_t)bidx * 2 + k) * FF + c) * 2;
                    *(f32x4*)o = (f32x4){gk[0], uk[0], gk[1], uk[1]}; *(f32x4*)(o + 4) = (f32x4){gk[2], uk[2], gk[3], uk[3]}; }
                gm2 = gm1; gm1 = gk;
            }
            if (!sample) {
                if (lastl) {
                    const int hb = bidx + 1;
                    *(f32x4*)(halo + ((size_t)hb * 2 + 0) * FF + c) = g6; *(f32x4*)(halo + ((size_t)hb * 2 + 1) * FF + c) = g7;
                    if ((hb & 15) == 0) { const int b = (hb >> 4) - 1; *(f32x4*)(convP + ((size_t)b * 2 + 0) * FF + c) = g6; *(f32x4*)(convP + ((size_t)b * 2 + 1) * FF + c) = g7; }
                }
            } else { *(f32x4*)(convS + ((size_t)sb * 2 + 0) * FF + c) = g6; *(f32x4*)(convS + ((size_t)sb * 2 + 1) * FF + c) = g7; }
        }
        if (sample) { asm volatile("s_waitcnt vmcnt(0)" ::: "memory"); if (lane_ == 0) xb_add(actcnt + (u.pm - 64) * 64, 1u); }
    }
};

struct TDesc { const float* W; const float* gk; const float* gn; bf16_t* WT; int N, ldk, dst_row0, k0, n0; };
struct TRegs { f32x4 v[8]; };
__device__ __forceinline__ void t_load(const TDesc& d, TRegs& t, int lane) {
    const int c4 = lane & 7;
    f32x4 gnv = (f32x4){1.f, 1.f, 1.f, 1.f};
    if (d.gn) gnv = *(const f32x4*)(d.gn + d.n0 + 4 * c4);
#pragma unroll
    for (int i = 0; i < 8; ++i) { const int kk = 8 * i + (lane >> 3); f32x4 v = __builtin_nontemporal_load((const f32x4*)(d.W + (size_t)(d.k0 + kk) * d.N + d.n0 + 4 * c4)) * gnv; if (d.gk) v *= d.gk[d.k0 + kk]; t.v[i] = v; }
}
__device__ __forceinline__ void t_store(const TDesc& d, const TRegs& t, LAS float* scr, int lane) {
    const int c4 = lane & 7;
#pragma unroll
    for (int i = 0; i < 8; ++i) { const int kk = 8 * i + (lane >> 3); LAS float* q = scr + kk * 33 + 4 * c4; q[0] = t.v[i][0]; q[1] = t.v[i][1]; q[2] = t.v[i][2]; q[3] = t.v[i][3]; }
    asm volatile("s_waitcnt lgkmcnt(0)" ::: "memory");
    const int c = lane & 7;
#pragma unroll
    for (int j = 0; j < 4; ++j) { const int n = (lane >> 3) + 8 * j; const LAS float* sp = scr + (8 * c) * 33 + n;
        u32x4 o; o.x = cvt_pk_bf16(sp[0 * 33], sp[1 * 33]); o.y = cvt_pk_bf16(sp[2 * 33], sp[3 * 33]); o.z = cvt_pk_bf16(sp[4 * 33], sp[5 * 33]); o.w = cvt_pk_bf16(sp[6 * 33], sp[7 * 33]);
        *(u32x4*)(d.WT + (size_t)(d.dst_row0 + n) * d.ldk + d.k0 + 8 * c) = o; }
    asm volatile("s_waitcnt lgkmcnt(0)" ::: "memory");
}
__device__ __forceinline__ void t_decode(const Params& P, int it, TDesc& d) {
    const int l = it / 5536; int r = it % 5536;
    d.gk = nullptr; d.gn = nullptr;
    if (r < 768) { const int kb = r / 48, nb = r % 48; d.W = P.in[I_WIN] + (size_t)l * D * INW; d.N = INW; d.gk = P.in[I_N1G] + l * D; d.WT = (bf16_t*)(P.ws + WS_WIN) + (size_t)l * INW * D; d.ldk = D; d.dst_row0 = 32 * nb; d.k0 = 64 * kb; d.n0 = 32 * nb; return; } r -= 768;
    if (r < 512) { const int kb = r / 32, nb = r % 32; d.W = P.in[I_WOUT] + (size_t)l * D * D; d.N = D; d.WT = (bf16_t*)(P.ws + WS_WOUT) + (size_t)l * D * D; d.ldk = D; d.dst_row0 = 32 * nb; d.k0 = 64 * kb; d.n0 = 32 * nb; return; } r -= 512;
    if (r < 2816) { const int up = r >= 1408; if (up) r -= 1408; const int kb = r / 88, nb = r % 88, n0 = 32 * nb; d.W = (up ? P.in[I_WUP] : P.in[I_WGATE]) + (size_t)l * D * FF; d.N = FF; d.gk = P.in[I_N2G] + l * D;
        d.WT = (bf16_t*)(P.ws + WS_WGU) + (size_t)l * NGU * D; d.ldk = D; d.dst_row0 = 256 * (n0 >> 7) + 128 * up + (n0 & 127); d.k0 = 64 * kb; d.n0 = n0; return; } r -= 2816;
    if (r < 1408) { const int kb = r / 32, nb = r % 32; d.W = P.in[I_WDOWN] + (size_t)l * FF * D; d.N = D; d.WT = (bf16_t*)(P.ws + WS_WDN) + (size_t)l * D * FF; d.ldk = FF; d.dst_row0 = 32 * nb; d.k0 = 64 * kb; d.n0 = 32 * nb; return; } r -= 1408;
    { const int gi = r >> 3, rr = r & 7, kb = rr >> 2, nb = rr & 3; d.W = P.in[I_POOLW] + (size_t)(l * 4 + gi) * 16384; d.N = 128; d.gn = P.in[I_PSCALE] + l * 512 + gi * 128;
      d.WT = (bf16_t*)(P.ws + WS_PWT) + (size_t)(l * 4 + gi) * 16384; d.ldk = 128; d.dst_row0 = 32 * nb; d.k0 = 64 * kb; d.n0 = 32 * nb; }
}

__device__ __forceinline__ void convert_weights(const Params& P, LAS unsigned char* lds, int layer, int lo, int hi, int gw, int NGW) {
    const int tid = opaque_tid(), lane = tid & 63, wid = tid >> 6;
    LAS float* scr = (LAS float*)(lds + wid * 8704);
    const int base = layer * 5536;
    int it = lo + gw;
    TDesc dc, dn; TRegs tc, tn;
    if (it < hi) { t_decode(P, base + it, dc); t_load(dc, tc, lane); }
    while (it < hi) {
        const int itn = it + NGW; const bool hn = itn < hi;
        if (hn) { t_decode(P, base + itn, dn); t_load(dn, tn, lane); }
        t_store(dc, tc, scr, lane);
        if (hn) { dc = dn; tc = tn; }
        it = itn;
    }
}

__device__ __forceinline__ void phase0(const Params& P, LAS unsigned char* lds) {
    const int tid = opaque_tid(), lane = tid & 63, wid = tid >> 6;
    const int gw = blockIdx.x * 8 + wid, NGW = gridDim.x * 8;
    const int gtid = blockIdx.x * 512 + tid, NT = gridDim.x * 512;
    float* stat = (float*)(P.ws + WS_STAT);
    { unsigned* bw = (unsigned*)(P.ws + WS_BAR); for (int i = gtid; i < XCD_BAR_WORDS + N_CNT * 64; i += NT) bw[i] = 0u; }
    bf16_t* xb = (bf16_t*)(P.ws + WS_XB);
    for (int row = gw; row < MT; row += NGW) {
        const float* xr = row < MP ? P.in[I_XP] + (size_t)row * D : P.in[I_XS] + (size_t)(row - MP) * D;
        f32x4 v[4]; float s = 0.f;
#pragma unroll
        for (int j = 0; j < 4; ++j) { v[j] = __builtin_nontemporal_load((const f32x4*)xr + lane + 64 * j); s += (v[j][0] * v[j][0] + v[j][1] * v[j][1]) + (v[j][2] * v[j][2] + v[j][3] * v[j][3]); }
        s = wave_sum(s);
#pragma unroll
        for (int j = 0; j < 4; ++j) { u32x2 w; w.x = cvt_pk_bf16(v[j][0], v[j][1]); w.y = cvt_pk_bf16(v[j][2], v[j][3]); ((u32x2*)(xb + (size_t)row * D))[lane + 64 * j] = w; }
        if (lane < 16) stat[(size_t)row * 16 + lane] = lane == 0 ? s : 0.f;
    }
    convert_weights(P, lds, 0, 0, 768, gw, NGW);
    { const f32x4* sp = (const f32x4*)P.in[I_SPOOL]; f32x4* o = (f32x4*)(P.out + O_POOLS);
      for (int i = gtid; i < 4 * 128 * 7 * 128; i += NT) { const int c4 = i & 127, rr = (i >> 7) % 7, lb = (i >> 7) / 7; o[((size_t)lb * 15 + rr) * 128 + c4] = sp[((size_t)lb * 15 + rr + 8) * 128 + c4]; } }
    { bf16_t* WSB = (bf16_t*)(P.ws + WS_WSB); const float* wsp = P.in[I_WSP];
      for (int i = gtid; i < 4 * 4 * 128 * 128; i += NT) { const int s = i & 127, t = (i >> 7) & 127; WSB[i] = (s <= t) ? f2bf(wsp[i]) : (bf16_t)0; } }
}

constexpr int MLD = 136;
template <int W> __device__ __forceinline__ void pool_sample_stage(const Params& P, int layer, int gi, int tt, LAS bf16_t* sA, int tid) {
    const bf16_t* ZP = (const bf16_t*)(P.ws + WS_R1 + R1_ZP);
    const int r0 = tt * 128;
#pragma unroll 2
    for (int q_ = 0; q_ < 4; ++q_) {
        const int pi = tid + 512 * q_;
        const int c = pi & 127, bl = pi >> 7; const int b = (tt - 128) * 16 + bl;
        const float* sp = P.in[I_SPOOL] + (((size_t)layer * 128 + b) * 15) * 512 + 128 * gi + c;
        float full[23];
#pragma unroll
        for (int i = 0; i < 15; ++i) full[i] = (i >= 16 - W) ? sp[(size_t)i * 512] : 0.f;
        const bf16_t* zp = ZP + (size_t)(r0 + bl * 8) * 512 + 128 * gi + c;
#pragma unroll
        for (int t = 0; t < 8; ++t) full[15 + t] = bf2f(zp[(size_t)t * 512]);
#pragma unroll
        for (int t = 0; t < 8; ++t) { float s = 0.f;
#pragma unroll
            for (int i = 0; i < W; ++i) s += full[15 + t - i];
            sA[(bl * 8 + t) * MLD + c] = f2bf(s * (1.0f / W) - full[15 + t]); }
    }
}

__device__ __forceinline__ void mixer_phase(const Params& P, int layer, LAS unsigned char* lds, int c2, int G2) {
    const int tid = opaque_tid(), lane = tid & 63, wid = tid >> 6;
    LAS bf16_t* sA = (LAS bf16_t*)lds;
    LAS bf16_t* sB = (LAS bf16_t*)(lds + 34816);
    LAS bf16_t* sP = (LAS bf16_t*)(lds + 69632);
    const bf16_t* ZP = (const bf16_t*)(P.ws + WS_R1 + R1_ZP); const bf16_t* ZU = (const bf16_t*)(P.ws + WS_R1 + R1_ZU); const bf16_t* ZV = (const bf16_t*)(P.ws + WS_R1 + R1_ZV);
    bf16_t* MIX = (bf16_t*)(P.ws + WS_R1 + R1_MIX);
    const float* vss = (const float*)(P.ws + WS_VSP);
    for (int it2 = c2; it2 < 1088; it2 += G2) {
        const int it = it2 < 64 ? 1024 + it2 : it2 - 64;
        const int tt = it >> 3, j = it & 7, r0 = tt * 128;
        const bool sample = tt >= 128;
        if (j < 4) {
            const int gi = j;
            const bf16_t* pw = (const bf16_t*)(P.ws + WS_PWT) + (size_t)(layer * 4 + gi) * 16384;
#pragma unroll
            for (int q_ = 0; q_ < 4; ++q_) { const int e = tid + 512 * q_; const int n = e >> 4, ch = e & 15; *(LAS u32x4*)(sB + n * MLD + ch * 8) = *(const u32x4*)(pw + n * 128 + ch * 8); }
            if (!sample) {
                const bf16_t* zp = ZP + 128 * gi;
#pragma unroll
                for (int q_ = 0; q_ < 5; ++q_) { const int e = tid + 512 * q_; if (e >= 143 * 16) break; const int row = e >> 4, ch = e & 15; const int grow = r0 - 15 + row; u32x4 v = (u32x4){0u, 0u, 0u, 0u};
                    if (row >= 15 || (tt & 15) != 0) v = *(const u32x4*)(zp + (size_t)grow * 512 + ch * 8);
                    *(LAS u32x4*)(sP + row * 128 + ch * 8) = v; }
                __syncthreads();
                const int ch = tid & 15, seg = tid >> 4; const int w = 2 << gi;
                const int tpos0 = (r0 & 2047) + seg * 4;
                float sm[8];
#pragma unroll
                for (int q = 0; q < 8; ++q) sm[q] = 0.f;
                for (int i = 1; i < w; ++i) { const u32x4 pr = *(const LAS u32x4*)(sP + (15 + seg * 4 - i) * 128 + ch * 8);
                    sm[0] += bflo(pr.x); sm[1] += bfhi(pr.x); sm[2] += bflo(pr.y); sm[3] += bfhi(pr.y); sm[4] += bflo(pr.z); sm[5] += bfhi(pr.z); sm[6] += bflo(pr.w); sm[7] += bfhi(pr.w); }
#pragma unroll
                for (int rr = 0; rr < 4; ++rr) {
                    const int row = seg * 4 + rr;
                    const u32x4 pr = *(const LAS u32x4*)(sP + (15 + row) * 128 + ch * 8);
                    float pv[8] = {bflo(pr.x), bfhi(pr.x), bflo(pr.y), bfhi(pr.y), bflo(pr.z), bfhi(pr.z), bflo(pr.w), bfhi(pr.w)};
                    const float inv = 1.0f / (float)min(tpos0 + rr + 1, w);
                    float dv[8];
#pragma unroll
                    for (int q = 0; q < 8; ++q) { sm[q] += pv[q]; dv[q] = sm[q] * inv - pv[q]; }
                    u32x4 o; o.x = cvt_pk_bf16(dv[0], dv[1]); o.y = cvt_pk_bf16(dv[2], dv[3]); o.z = cvt_pk_bf16(dv[4], dv[5]); o.w = cvt_pk_bf16(dv[6], dv[7]);
                    *(LAS u32x4*)(sA + row * MLD + ch * 8) = o;
                    const u32x4 ps = *(const LAS u32x4*)(sP + (15 + row - w + 1) * 128 + ch * 8);
                    sm[0] -= bflo(ps.x); sm[1] -= bfhi(ps.x); sm[2] -= bflo(ps.y); sm[3] -= bfhi(ps.y); sm[4] -= bflo(ps.z); sm[5] -= bfhi(ps.z); sm[6] -= bflo(ps.w); sm[7] -= bfhi(ps.w);
                }
            } else {
                if (gi == 0) pool_sample_stage<2>(P, layer, gi, tt, sA, tid);
                else if (gi == 1) pool_sample_stage<4>(P, layer, gi, tt, sA, tid);
                else if (gi == 2) pool_sample_stage<8>(P, layer, gi, tt, sA, tid);
                else pool_sample_stage<16>(P, layer, gi, tt, sA, tid);
            }
        } else {
            const int h = j - 4;
            const bf16_t* wsb = (const bf16_t*)(P.ws + WS_WSB) + (size_t)(layer * 4 + h) * 16384;
            if (!sample) {
#pragma unroll
                for (int q_ = 0; q_ < 4; ++q_) { const int e = tid + 512 * q_; const int row = e >> 4, ch = e & 15; *(LAS u32x4*)(sA + row * MLD + ch * 8) = *(const u32x4*)(wsb + row * 128 + ch * 8); } }
            else {
#pragma unroll
                for (int q_ = 0; q_ < 4; ++q_) { const int e = tid + 512 * q_; const int i = e >> 4, ch = e & 15; u32x4 v = (u32x4){0u, 0u, 0u, 0u}; if (ch == (i >> 3)) v = *(const u32x4*)(wsb + (i & 7) * 128); *(LAS u32x4*)(sA + i * MLD + ch * 8) = v; } }
            const bf16_t* zv = ZV + 128 * h; const float* gv = P.in[I_VNG] + layer * 512 + 128 * h;
#pragma unroll
            for (int q_ = 0; q_ < 4; ++q_) {
                const int e = tid + 512 * q_;
                const int s = e >> 4, ch = e & 15, row = r0 + s;
                const u32x4 raw = *(const u32x4*)(zv + (size_t)row * 512 + ch * 8);
                const f32x4 va = *(const f32x4*)(vss + (size_t)row * 8), vb = *(const f32x4*)(vss + (size_t)row * 8 + 4);
                const float rs = rsqrtf((((va[0] + va[1]) + (va[2] + va[3])) + ((vb[0] + vb[1]) + (vb[2] + vb[3]))) * (1.0f / 512.0f) + EPS);
                const f32x4 g0 = *(const f32x4*)(gv + ch * 8), g1 = *(const f32x4*)(gv + ch * 8 + 4);
                f32x4 v0, v1;
                v0[0] = bflo(raw.x) * rs * g0[0]; v0[1] = bfhi(raw.x) * rs * g0[1]; v0[2] = bflo(raw.y) * rs * g0[2]; v0[3] = bfhi(raw.y) * rs * g0[3];
                v1[0] = bflo(raw.z) * rs * g1[0]; v1[1] = bfhi(raw.z) * rs * g1[1]; v1[2] = bflo(raw.w) * rs * g1[2]; v1[3] = bfhi(raw.w) * rs * g1[3];
#pragma unroll
                for (int jj = 0; jj < 4; ++jj) { sB[(ch * 8 + jj) * MLD + s] = f2bf(v0[jj]); sB[(ch * 8 + 4 + jj) * MLD + s] = f2bf(v1[jj]); }
                if (sample) { float* o = P.out + O_VS + ((size_t)layer * 1024 + (row - MP)) * 512 + 128 * h + ch * 8; *(f32x4*)o = v0; *(f32x4*)(o + 4) = v1; }
            }
        }
        __syncthreads();
        f32x4 acc[8];
#pragma unroll
        for (int nb = 0; nb < 8; ++nb) acc[nb] = (f32x4){0.f, 0.f, 0.f, 0.f};
        const int lr = lane & 15, kq = lane >> 4;
#pragma unroll
        for (int ks = 0; ks < 4; ++ks) {
            const bf16x8 a = *(const LAS bf16x8*)(sA + (16 * wid + lr) * MLD + ks * 32 + kq * 8);
#pragma unroll
            for (int nb = 0; nb < 8; ++nb) { const bf16x8 b = *(const LAS bf16x8*)(sB + (16 * nb + lr) * MLD + ks * 32 + kq * 8); acc[nb] = __builtin_amdgcn_mfma_f32_16x16x32_bf16(b, a, acc[nb], 0, 0, 0); }
        }
        const int row = 16 * wid + lr, grow = r0 + row;
        if (j < 4) {
#pragma unroll
            for (int nb = 0; nb < 8; ++nb) { u32x2 w; w.x = cvt_pk_bf16(acc[nb][0], acc[nb][1]); w.y = cvt_pk_bf16(acc[nb][2], acc[nb][3]); bf16_t* o = MIX + (size_t)grow * D + 128 * j + 16 * nb + 4 * kq; if (sample) st_wt64(o, w); else *(u32x2*)o = w; }
        } else {
            const int h = j - 4;
            const float bias = P.in[I_BSP][(layer * 4 + h) * 128 + (sample ? (row & 7) : row)];
#pragma unroll
            for (int nb = 0; nb < 8; ++nb) { const int col = 128 * h + 16 * nb + 4 * kq; const u32x2 uu = *(const u32x2*)(ZU + (size_t)grow * 512 + col);
                u32x2 w; w.x = cvt_pk_bf16(bflo(uu.x) * (acc[nb][0] + bias), bfhi(uu.x) * (acc[nb][1] + bias)); w.y = cvt_pk_bf16(bflo(uu.y) * (acc[nb][2] + bias), bfhi(uu.y) * (acc[nb][3] + bias));
                bf16_t* o = MIX + (size_t)grow * D + 512 + col; if (sample) st_wt64(o, w); else *(u32x2*)o = w; }
        }
        if (sample) asm volatile("s_waitcnt vmcnt(0)" ::: "memory");
        __syncthreads();
        if (sample && tid == 0) xb_add(cnt_word(P.ws, layer, 0, (tt - 128) >> 1), 1u);
    }
}

__device__ __forceinline__ void patch_panel_quarter(const Params& P, int layer, int pm, int pn) {
    const int tid = opaque_tid();
    const float* halo = (const float*)(P.ws + WS_HALO); const float* fix = (const float*)(P.ws + WS_FIX);
    const float* cw = P.in[I_CONVW] + (size_t)layer * 3 * FF; const float* cb = P.in[I_CONVB] + (size_t)layer * FF;
    bf16_t* act = (bf16_t*)(P.ws + WS_R1);
    if (tid < 352) {
        const int b = tid / 176, g4 = tid % 176, bidx = 2 * pm + b, c = 704 * pn + 4 * g4;
        if ((bidx & 15) != 0) {
            const f32x4 h2 = *(const f32x4*)(halo + ((size_t)bidx * 2 + 0) * FF + c), h1 = *(const f32x4*)(halo + ((size_t)bidx * 2 + 1) * FF + c);
            const float* f0 = fix + (((size_t)bidx * 2 + 0) * FF + c) * 2; const float* f1 = fix + (((size_t)bidx * 2 + 1) * FF + c) * 2;
            const f32x4 a0 = *(const f32x4*)f0, a1 = *(const f32x4*)(f0 + 4), b0 = *(const f32x4*)f1, b1 = *(const f32x4*)(f1 + 4);
            const f32x4 g0 = (f32x4){a0[0], a0[2], a1[0], a1[2]}, u0 = (f32x4){a0[1], a0[3], a1[1], a1[3]}, g1 = (f32x4){b0[0], b0[2], b1[0], b1[2]}, u1 = (f32x4){b0[1], b0[3], b1[1], b1[3]};
            const f32x4 w0 = *(const f32x4*)(cw + c), w1 = *(const f32x4*)(cw + FF + c), w2 = *(const f32x4*)(cw + 2 * FF + c), bb = *(const f32x4*)(cb + c);
            const f32x4 r0 = gelu4(bb + w0 * h2 + w1 * h1 + w2 * g0) * u0, r1 = gelu4(bb + w0 * h1 + w1 * g0 + w2 * g1) * u1;
            const size_t T = (size_t)128 * bidx;
            u32x2 o; o.x = cvt_pk_bf16(r0[0], r0[1]); o.y = cvt_pk_bf16(r0[2], r0[3]); st_wt64(act + T * FF + c, o);
            o.x = cvt_pk_bf16(r1[0], r1[1]); o.y = cvt_pk_bf16(r1[2], r1[3]); st_wt64(act + (T + 1) * FF + c, o);
        }
    }
    asm volatile("s_waitcnt vmcnt(0)" ::: "memory");
    __syncthreads();
    if (tid == 0) xb_add(pcnt_word(P.ws, layer, pm), 1u);
    wait_count(pcnt_word(P.ws, layer, pm), 4u, (unsigned*)(P.ws + WS_BAR) + XB_TMO);
}

__device__ __forceinline__ void final_phase(const Params& P) {
    const int tid = opaque_tid(), lane = tid & 63, wid = tid >> 6;
    const int gw = blockIdx.x * 8 + wid, NGW = gridDim.x * 8;
    const float* ssf = (const float*)(P.ws + WS_STAT);
    const f32x4* gf = (const f32x4*)P.in[I_FNG];
    const bf16_t* xb = (const bf16_t*)(P.ws + WS_XB);
    for (int row = gw; row < MT; row += NGW) {
        const float rs = rsqrtf(sum16(ssf + (size_t)row * 16) * (1.0f / 1024.0f) + EPS);
        f32x4* yr = (f32x4*)(P.out + (size_t)row * D);
        const u32x2* xr = (const u32x2*)(xb + (size_t)row * D);
#pragma unroll
        for (int j = 0; j < 4; ++j) { const u32x2 r = xr[lane + 64 * j]; const f32x4 v = (f32x4){bflo(r.x), bfhi(r.x), bflo(r.y), bfhi(r.y)}; __builtin_nontemporal_store(v * rs * gf[lane + 64 * j], yr + lane + 64 * j); }
    }
}

__global__ __launch_bounds__(512, 2) void fwd_kernel(Params P) {
    extern __shared__ __attribute__((aligned(16))) unsigned char shm[];
    LAS unsigned char* lds = (LAS unsigned char*)shm;
    cg::grid_group grid = cg::this_grid();
    volatile LAS unsigned* xst = (volatile LAS unsigned*)(lds + 131072);
    if (threadIdx.x == 0) { xst[0] = 0u; xst[1] = 0u; }
    __syncthreads();
    phase0(P, lds);
    grid.sync();
    const XcdBarrier xb = xcd_barrier_post((unsigned*)(P.ws + WS_BAR), xst);
    float* stat = (float*)(P.ws + WS_STAT);
    bf16_t* XB = (bf16_t*)(P.ws + WS_XB);
    unsigned char* R1 = P.ws + WS_R1;
#pragma unroll 1
    for (int l = 0; l < 4; ++l) {
        {
            pg8::Gemm g{XB, (const bf16_t*)(P.ws + WS_WIN) + (size_t)l * INW * D, MT, INW, D};
            pg8::StaticOrder S; S.init(MT, INW, (int)gridDim.x, (int)blockIdx.x);
            EpiA E{stat, (bf16_t*)(R1 + R1_ZP), (float*)(P.ws + WS_VSP),
                   P.out + O_POOLP + (size_t)l * 8 * 15 * 512, P.out + O_POOLS + (size_t)l * 128 * 15 * 512};
            pg8::gemm_phase(lds, g, S, E);
            if (l == 0 && blockIdx.x >= 152) convert_weights(P, lds, 0, 768, 5536, ((int)blockIdx.x - 152) * 8 + (opaque_tid() >> 6), ((int)gridDim.x - 152) * 8);
        }
        xcd_barrier(xb);
        unsigned* tmo = (unsigned*)(P.ws + WS_BAR) + XB_TMO;
        if (blockIdx.x < 16) {
            const int panel = blockIdx.x >> 2;
            wait_count(cnt_word(P.ws, l, 0, panel), 16u, tmo);
            pg8::Gemm g{(const bf16_t*)(R1 + R1_MIX), (const bf16_t*)(P.ws + WS_WOUT) + (size_t)l * D * D, MT, D, D};
            pg8::OneUnit S{64 + panel, (int)(blockIdx.x & 3)};
            { EpiX<false> E{P.in[I_XP], P.in[I_XS], XB, stat}; pg8::gemm_phase(lds, g, S, E); }
        } else mixer_phase(P, l, lds, (int)blockIdx.x - 16, (int)gridDim.x - 16);
        xcd_barrier(xb);
        {
            pg8::Gemm g{(const bf16_t*)(R1 + R1_MIX), (const bf16_t*)(P.ws + WS_WOUT) + (size_t)l * D * D, MP, D, D};
            pg8::StaticOrder S; S.init(MP, D, (int)gridDim.x, (int)blockIdx.x);
            { EpiX<false> E{P.in[I_XP], P.in[I_XS], XB, stat}; pg8::gemm_phase(lds, g, S, E); }
        }
        xcd_barrier(xb);
        {
            pg8::Gemm g{XB, (const bf16_t*)(P.ws + WS_WGU) + (size_t)l * NGU * D, MT, NGU, D};
            pg8::COrder S; S.so.init(MP, NGU, 256, 0); S.c = (int)blockIdx.x; S.seg = 0;
            EpiC E{stat, P.in[I_CONVW] + (size_t)l * 3 * FF, P.in[I_CONVB] + (size_t)l * FF, P.in[I_SCONV] + (size_t)l * 128 * 2 * FF,
                   (bf16_t*)R1, (float*)(P.ws + WS_HALO), (float*)(P.ws + WS_FIX), P.out + O_CONVP + (size_t)l * 8 * 2 * FF, P.out + O_CONVS + (size_t)l * 128 * 2 * FF, cnt_word(P.ws, l, 1, 0)};
            pg8::gemm_phase(lds, g, S, E);
            if (l < 3 && blockIdx.x < 240) convert_weights(P, lds, l + 1, 0, 5536, (int)blockIdx.x * 8 + (opaque_tid() >> 6), 240 * 8);
            if (blockIdx.x >= 240) {
                const int su = (int)blockIdx.x - 240, panel = su >> 2;
                wait_count(cnt_word(P.ws, l, 1, panel), 176u, tmo);
                pg8::Gemm gd{(const bf16_t*)R1, (const bf16_t*)(P.ws + WS_WDN) + (size_t)l * D * FF, MT, D, FF};
                pg8::OneUnit Sd{64 + panel, su & 3};
                EpiX<false> Ed{P.in[I_XP], P.in[I_XS], XB, stat};
                pg8::gemm_phase(lds, gd, Sd, Ed);
                S.seg = 1;
                pg8::gemm_phase(lds, g, S, E);
            }
        }
        xcd_barrier(xb);
        {
            pg8::Gemm g{(const bf16_t*)R1, (const bf16_t*)(P.ws + WS_WDN) + (size_t)l * D * FF, MP, D, FF};
            pg8::StaticOrder S; S.init(MP, D, (int)gridDim.x, (int)blockIdx.x);
            { pg8::Unit u0; if (S.next(0, u0)) patch_panel_quarter(P, l, u0.pm, u0.pn); }
            EpiX<false> E{P.in[I_XP], P.in[I_XS], XB, stat};
            pg8::gemm_phase(lds, g, S, E);
        }
        xcd_barrier(xb);
    }
    final_phase(P);
}

extern "C" void kernel_launch(void* const* d_in, const int* in_sizes, int n_in, void* d_out, int out_size, void* d_ws, size_t ws_size, hipStream_t stream) {
    static int grid_blocks = 0;
    if (grid_blocks == 0) {
        if (n_in != 19 || ws_size < WS_END) { fprintf(stderr, "kernel_launch: unexpected n_in %d or ws_size %zu (< %zu)\n", n_in, ws_size, (size_t)WS_END); grid_blocks = -1; return; }
        int dev = 0, cus = 0, per_cu = 0;
        hipGetDevice(&dev);
        hipDeviceGetAttribute(&cus, hipDeviceAttributeMultiprocessorCount, dev);
        if (hipFuncSetAttribute((const void*)fwd_kernel, hipFuncAttributeMaxDynamicSharedMemorySize, LDS_BYTES) != hipSuccess) { fprintf(stderr, "kernel_launch: hipFuncSetAttribute failed\n"); grid_blocks = -1; return; }
        hipOccupancyMaxActiveBlocksPerMultiprocessor(&per_cu, (const void*)fwd_kernel, 512, LDS_BYTES);
        if (per_cu < 1) { fprintf(stderr, "kernel_launch: occupancy query says %d blocks per CU\n", per_cu); per_cu = 1; }
        (void)hipGetLastError();
        grid_blocks = cus * per_cu;
        if (grid_blocks != 256) { fprintf(stderr, "kernel_launch: this build schedules for exactly 256 workgroups, got %d\n", grid_blocks); grid_blocks = 256; }
    }
    if (grid_blocks < 0) return;
    Params p{};
    for (int i = 0; i < 19; ++i) p.in[i] = (const float*)d_in[i];
    p.out = (float*)d_out; p.ws = (unsigned char*)d_ws;
    void* args[] = {&p};
    hipError_t e = hipLaunchCooperativeKernel((const void*)fwd_kernel, dim3(grid_blocks), dim3(512), args, LDS_BYTES, stream);
    if (e != hipSuccess) fprintf(stderr, "cooperative launch failed: %s (grid %d)\n", hipGetErrorString(e), grid_blocks);
}
```
